# Optimizing an MI355X kernel written in HIP

```python
import math
import jax, jax.numpy as jnp
from jax import lax
import numpy as np

D_MODEL = 2048
BATCH = 4
SEQ = 4096
DEPTH = 2

HEAD_DIM = 128
FOX_HEADS = D_MODEL // (2 * HEAD_DIM)
NSA_HEADS = D_MODEL // (2 * HEAD_DIM)
NSA_GROUP_SIZE = 4
NSA_KV_GROUPS = NSA_HEADS // NSA_GROUP_SIZE
FOX_W = FOX_HEADS * HEAD_DIM
NSA_W = NSA_HEADS * HEAD_DIM
NSA_KV_W = NSA_KV_GROUPS * HEAD_DIM
ROPE_DIM = HEAD_DIM // 4
ROPE_THETA = 500000.0
CMP_LEN = 32
CMP_STRIDE = 16
CMP_HIDDEN = 256
SLC_LEN = 64
SLC_TOP = 16
WINDOW = 512
FOX_Q_BLOCK = 128
NSA_Q_BLOCK = 64
FFN_HIDDEN = ((8 * D_MODEL + 3 * 256 - 1) // (3 * 256)) * 256
EPS = 1e-6
NEG_INF = -1e30
FORCE_SCORE = 1e6
IN_SIZES = [FOX_W, FOX_W, FOX_W, FOX_HEADS, NSA_W,
            NSA_KV_W, NSA_KV_W, NSA_KV_W, NSA_KV_W, NSA_KV_W, NSA_KV_W,
            NSA_HEADS * 3, D_MODEL, D_MODEL]
IN_W = sum(IN_SIZES)

kernel_name = "fox_nsa_parallel_hybrid"


def rms_norm(x, g):
    xf = x.astype(jnp.float32)
    y = xf * lax.rsqrt(jnp.mean(xf * xf, axis=-1, keepdims=True) + EPS) * g.astype(jnp.float32)
    return y.astype(x.dtype)


def partial_rope(x, pos):
    half = ROPE_DIM // 2
    inv_freq = jnp.power(ROPE_THETA, -jnp.arange(half, dtype=jnp.float32) * (2.0 / ROPE_DIM))
    ang = pos[:, None] * inv_freq[None, :]
    cos = jnp.cos(ang)[:, None, :]
    sin = jnp.sin(ang)[:, None, :]
    xf = x.astype(jnp.float32)
    x1 = xf[..., :half]
    x2 = xf[..., half:ROPE_DIM]
    out = jnp.concatenate([x1 * cos - x2 * sin, x2 * cos + x1 * sin, xf[..., ROPE_DIM:]], axis=-1)
    return out.astype(x.dtype)


def fox_attention(q, k, v, fg_logit, f_bias):
    B, T, H, Dh = q.shape
    QB = FOX_Q_BLOCK
    nblk = T // QB
    log_f = jax.nn.log_sigmoid(fg_logit.astype(jnp.float32) + f_bias.astype(jnp.float32))
    cum = jnp.cumsum(log_f, axis=1)
    cum_ht = cum.transpose(0, 2, 1)
    qb = q.reshape(B, nblk, QB, H, Dh).transpose(1, 0, 2, 3, 4)
    cb = cum.reshape(B, nblk, QB, H).transpose(1, 0, 3, 2)
    starts = jnp.arange(nblk) * QB
    kpos = jnp.arange(T)
    scale = HEAD_DIM ** -0.5

    def block(args):
        q_blk, c_blk, start = args
        s = jnp.einsum('bqhd,bkhd->bhqk', q_blk, k, preferred_element_type=jnp.float32) * scale
        s = s + (c_blk[..., :, None] - cum_ht[:, :, None, :])
        qpos = start + jnp.arange(QB)
        s = jnp.where(kpos[None, :] <= qpos[:, None], s, -jnp.inf)
        p = jax.nn.softmax(s, axis=-1)
        return jnp.einsum('bhqk,bkhd->bqhd', p.astype(v.dtype), v)

    o = lax.map(block, (qb, cb, starts))
    return o.transpose(1, 0, 2, 3, 4).reshape(B, T, H * Dh)


def compress_blocks(kv, pe, w1, w2):
    B, T, G, Dh = kv.shape
    nc = (T - CMP_LEN) // CMP_STRIDE + 1
    idx = np.arange(nc)[:, None] * CMP_STRIDE + np.arange(CMP_LEN)[None, :]
    blocks = kv[:, idx] + pe[None, None, :, None, :]
    blocks = blocks.transpose(0, 1, 3, 2, 4).reshape(B, nc, G, CMP_LEN * Dh)
    h = jax.nn.gelu(blocks @ w1)
    return h @ w2


def block_overlap(nc, nb):
    sc = np.arange(nc) * CMP_STRIDE
    ss = np.arange(nb) * SLC_LEN
    ov = np.minimum(sc[:, None] + CMP_LEN, ss[None, :] + SLC_LEN) - np.maximum(sc[:, None], ss[None, :])
    return (np.clip(ov, 0, None) / CMP_LEN).astype(np.float32)


def nsa_attention(q, kc, vc, ks, vs, kw, vw, gate_logit):
    B, T, H, Dh = q.shape
    G, HG = NSA_KV_GROUPS, NSA_GROUP_SIZE
    nc = kc.shape[1]
    nb = T // SLC_LEN
    n_sel = min(SLC_TOP, nb)
    QB = NSA_Q_BLOCK
    nq = T // QB
    scale = HEAD_DIM ** -0.5
    cmp_end = jnp.arange(nc) * CMP_STRIDE + CMP_LEN - 1
    overlap = jnp.asarray(block_overlap(nc, nb))
    ks_blk = ks.reshape(B, nb, SLC_LEN, G, Dh).transpose(0, 3, 1, 2, 4)
    vs_blk = vs.reshape(B, nb, SLC_LEN, G, Dh).transpose(0, 3, 1, 2, 4)
    kw_pad = jnp.pad(kw, ((0, 0), (WINDOW, 0), (0, 0), (0, 0)))
    vw_pad = jnp.pad(vw, ((0, 0), (WINDOW, 0), (0, 0), (0, 0)))
    gather = jax.vmap(jax.vmap(lambda blk, ix: blk[ix]))
    qc = q.reshape(B, nq, QB, G, HG, Dh).transpose(1, 0, 2, 3, 4, 5)
    gc = jax.nn.sigmoid(gate_logit.astype(jnp.float32)).reshape(B, nq, QB, G, HG, 3).transpose(1, 0, 2, 3, 4, 5)
    starts = jnp.arange(nq) * QB
    blk_ids = jnp.arange(nb)

    def block(args):
        q_blk, g_blk, start = args
        qpos = start + jnp.arange(QB)
        s_c = jnp.einsum('bqghd,bngd->bghqn', q_blk, kc, preferred_element_type=jnp.float32) * scale
        valid_c = cmp_end[None, :] <= qpos[:, None]
        s_c = jnp.where(valid_c, s_c, NEG_INF)
        p_c = jax.nn.softmax(s_c, axis=-1) * jnp.any(valid_c, axis=-1)[:, None].astype(jnp.float32)
        o_c = jnp.einsum('bghqn,bngd->bqghd', p_c.astype(vc.dtype), vc)
        imp = jnp.einsum('bghqn,nj->bgqj', p_c, overlap)
        cur = qpos // SLC_LEN
        forced = (blk_ids[None, :] == 0) | (blk_ids[None, :] == cur[:, None]) | (blk_ids[None, :] == cur[:, None] - 1)
        future = blk_ids[None, :] > cur[:, None]
        imp = jnp.where(forced, FORCE_SCORE, jnp.where(future, -1.0, imp))
        top_val, top_idx = lax.top_k(imp, n_sel)
        k_sel = gather(ks_blk, top_idx)
        v_sel = gather(vs_blk, top_idx)
        s_s = jnp.einsum('bqghd,bgqnld->bghqnl', q_blk, k_sel, preferred_element_type=jnp.float32) * scale
        kpos_s = top_idx[..., None] * SLC_LEN + jnp.arange(SLC_LEN)
        valid_s = (kpos_s <= qpos[None, None, :, None, None]) & (top_val >= 0.0)[..., None]
        s_s = jnp.where(valid_s[:, :, None], s_s, NEG_INF)
        p_s = jax.nn.softmax(s_s.reshape(B, G, HG, QB, n_sel * SLC_LEN), axis=-1)
        p_s = p_s.reshape(B, G, HG, QB, n_sel, SLC_LEN)
        o_s = jnp.einsum('bghqnl,bgqnld->bqghd', p_s.astype(v_sel.dtype), v_sel)
        k_win = lax.dynamic_slice_in_dim(kw_pad, start, WINDOW + QB, axis=1)
        v_win = lax.dynamic_slice_in_dim(vw_pad, start, WINDOW + QB, axis=1)
        kpos_w = start - WINDOW + jnp.arange(WINDOW + QB)
        dist = qpos[:, None] - kpos_w[None, :]
        valid_w = (dist >= 0) & (dist < WINDOW) & (kpos_w[None, :] >= 0)
        s_w = jnp.einsum('bqghd,bkgd->bghqk', q_blk, k_win, preferred_element_type=jnp.float32) * scale
        s_w = jnp.where(valid_w, s_w, NEG_INF)
        p_w = jax.nn.softmax(s_w, axis=-1)
        o_w = jnp.einsum('bghqk,bkgd->bqghd', p_w.astype(v_win.dtype), v_win)
        o = g_blk[..., 0:1] * o_c + g_blk[..., 1:2] * o_s + g_blk[..., 2:3] * o_w
        return o.astype(q.dtype)

    o = lax.map(block, (qc, gc, starts))
    return o.transpose(1, 0, 2, 3, 4, 5).reshape(B, T, H * Dh)


def hybrid_layer(x, n_mix_pre, n_mix_post, n_ffn_pre, n_ffn_post, w_in, f_bias,
                 ck_pe, ck_w1, ck_w2, cv_pe, cv_w1, cv_w2,
                 w_up_fox, w_up_nsa, w_out, w_gate, w_up, w_down):
    B, T, _ = x.shape
    a = rms_norm(x, n_mix_pre)
    proj = a @ w_in
    split_pts = np.cumsum(IN_SIZES)[:-1].tolist()
    (fq, fk, fv, ff, nq_, nkc, nvc, nks, nvs, nkw, nvw, ngate, g_fox, g_nsa) = jnp.split(proj, split_pts, axis=-1)
    pos = jnp.arange(T, dtype=jnp.float32)
    fq = fq.reshape(B, T, FOX_HEADS, HEAD_DIM)
    fk = fk.reshape(B, T, FOX_HEADS, HEAD_DIM)
    fv = fv.reshape(B, T, FOX_HEADS, HEAD_DIM)
    o_fox = fox_attention(fq, fk, fv, ff, f_bias)
    kv_shape = (B, T, NSA_KV_GROUPS, HEAD_DIM)
    nq_ = partial_rope(nq_.reshape(B, T, NSA_HEADS, HEAD_DIM), pos)
    nks = partial_rope(nks.reshape(kv_shape), pos)
    nkw = partial_rope(nkw.reshape(kv_shape), pos)
    kc = compress_blocks(nkc.reshape(kv_shape), ck_pe, ck_w1, ck_w2)
    vc = compress_blocks(nvc.reshape(kv_shape), cv_pe, cv_w1, cv_w2)
    nc = kc.shape[1]
    kc = partial_rope(kc, (jnp.arange(nc) * CMP_STRIDE + CMP_LEN - 1).astype(jnp.float32))
    o_nsa = nsa_attention(nq_, kc, vc, nks, nvs.reshape(kv_shape), nkw, nvw.reshape(kv_shape), ngate)
    mix = jax.nn.sigmoid(g_fox) * (o_fox @ w_up_fox) + jax.nn.sigmoid(g_nsa) * (o_nsa @ w_up_nsa)
    x = x + rms_norm(mix @ w_out, n_mix_post)
    a = rms_norm(x, n_ffn_pre)
    h = (jax.nn.silu(a @ w_gate) * (a @ w_up)) @ w_down
    return x + rms_norm(h, n_ffn_post)


def setup_inputs(seed: int = 0) -> dict:
    key = jax.random.key(seed)
    ks = jax.random.split(key, 24)
    f32 = jnp.float32

    def w(k, shape, fan_in):
        return jax.random.normal(k, shape, f32) * (fan_in ** -0.5)

    def gain(k):
        return 1.0 + 0.02 * jax.random.normal(k, (DEPTH, D_MODEL), f32)

    L = DEPTH
    return {
        "x": jax.random.normal(ks[0], (BATCH, SEQ, D_MODEL), f32),
        "norm_mix_pre": gain(ks[1]),
        "norm_mix_post": gain(ks[2]),
        "norm_ffn_pre": gain(ks[3]),
        "norm_ffn_post": gain(ks[4]),
        "w_in": w(ks[5], (L, D_MODEL, IN_W), D_MODEL),
        "fox_forget_bias": jax.random.uniform(ks[6], (L, FOX_HEADS), f32, 1.0, 4.0),
        "cmp_k_pe": 0.1 * jax.random.normal(ks[7], (L, CMP_LEN, HEAD_DIM), f32),
        "cmp_k_w1": w(ks[8], (L, CMP_LEN * HEAD_DIM, CMP_HIDDEN), CMP_LEN * HEAD_DIM),
        "cmp_k_w2": w(ks[9], (L, CMP_HIDDEN, HEAD_DIM), CMP_HIDDEN),
        "cmp_v_pe": 0.1 * jax.random.normal(ks[10], (L, CMP_LEN, HEAD_DIM), f32),
        "cmp_v_w1": w(ks[11], (L, CMP_LEN * HEAD_DIM, CMP_HIDDEN), CMP_LEN * HEAD_DIM),
        "cmp_v_w2": w(ks[12], (L, CMP_HIDDEN, HEAD_DIM), CMP_HIDDEN),
        "w_up_fox": w(ks[13], (L, FOX_W, D_MODEL), FOX_W),
        "w_up_nsa": w(ks[14], (L, NSA_W, D_MODEL), NSA_W),
        "w_out": w(ks[15], (L, D_MODEL, D_MODEL), D_MODEL),
        "w_ffn_gate": w(ks[16], (L, D_MODEL, FFN_HIDDEN), D_MODEL),
        "w_ffn_up": w(ks[17], (L, D_MODEL, FFN_HIDDEN), D_MODEL),
        "w_ffn_down": w(ks[18], (L, FFN_HIDDEN, D_MODEL), FFN_HIDDEN),
    }


def reference(x, norm_mix_pre, norm_mix_post, norm_ffn_pre, norm_ffn_post, w_in, fox_forget_bias,
              cmp_k_pe, cmp_k_w1, cmp_k_w2, cmp_v_pe, cmp_v_w1, cmp_v_w2,
              w_up_fox, w_up_nsa, w_out, w_ffn_gate, w_ffn_up, w_ffn_down):
    for l in range(DEPTH):
        x = hybrid_layer(x, norm_mix_pre[l], norm_mix_post[l], norm_ffn_pre[l], norm_ffn_post[l],
                         w_in[l], fox_forget_bias[l],
                         cmp_k_pe[l], cmp_k_w1[l], cmp_k_w2[l], cmp_v_pe[l], cmp_v_w1[l], cmp_v_w2[l],
                         w_up_fox[l], w_up_nsa[l], w_out[l], w_ffn_gate[l], w_ffn_up[l], w_ffn_down[l])
    return x
```

```cpp
#include <hip/hip_runtime.h>
#include <hip/hip_cooperative_groups.h>
#include <cstdio>
#include <cstdint>
namespace cg = cooperative_groups;

#define LAS __attribute__((address_space(3)))
typedef unsigned short bf16_t;
typedef short bf16x8 __attribute__((ext_vector_type(8)));
typedef short s16x4 __attribute__((ext_vector_type(4)));
typedef float f32x2 __attribute__((ext_vector_type(2)));
typedef float f32x4 __attribute__((ext_vector_type(4)));
typedef float f32x16 __attribute__((ext_vector_type(16)));
typedef unsigned u32x2 __attribute__((ext_vector_type(2)));
typedef unsigned u32x4 __attribute__((ext_vector_type(4)));

constexpr int NTOK = 16384, TT = 4096, DM = 2048, FFH = 5632, INW = 9760, INP = 9984;
constexpr float EPSN = 1e-6f;
constexpr float LOG2E = 1.4426950408889634f;
constexpr float SCALE = 0.08838834764831845f;
constexpr float C2 = LOG2E * SCALE;
constexpr int NTHR = 512;

constexpr size_t WS_CTL = 0;
constexpr size_t WS_ORDER = 4096;
constexpr size_t WS_ROPEQ = 8192;
constexpr size_t WS_ROPEC = WS_ROPEQ + 2 * 4096 * 16 * 4;
constexpr size_t WS_PEB = WS_ROPEC + 2 * 256 * 16 * 4;
constexpr size_t WS_CUM = WS_PEB + 2 * 32 * 256 * 4;
constexpr size_t WS_SMALL = WS_CUM + 32 * 4096 * 4;
constexpr size_t WS_SSQ = WS_SMALL + (size_t)NTOK * 32 * 4;
constexpr size_t WS_KC = WS_SSQ + (size_t)NTOK * 32 * 4;
constexpr size_t WS_VC = WS_KC + 8 * 256 * 128 * 2;
constexpr size_t WS_BAR = WS_VC + 8 * 256 * 128 * 2;
constexpr size_t WS_WT = WS_BAR + 16384;
constexpr size_t WT_IN = 0, WT_C1K = (size_t)INP * DM * 2, WT_C1V = WT_C1K + 256 * 4096 * 2;
constexpr size_t W2_UPF = 0, W2_UPN = 2048 * 1024 * 2, W2_OUT = 2 * 2048 * 1024 * 2;
constexpr size_t WT_GU = 0, WT_DOWN = (size_t)2 * FFH * DM * 2;
constexpr size_t WS_ABUF = WS_WT + 70 * 1024 * 1024;
constexpr size_t WS_PROJ = WS_ABUF + (size_t)NTOK * DM * 2;
constexpr size_t SZ_HM = (size_t)NTOK * 1024 * 2;
constexpr size_t SZ_KV = (size_t)NTOK * 256 * 2;
constexpr size_t PJ_FQ = 0, PJ_FK = SZ_HM, PJ_FV = 2 * SZ_HM, PJ_NQ = 3 * SZ_HM, PJ_KV = 4 * SZ_HM;
constexpr size_t PJ_GF = PJ_KV + 6 * SZ_KV, PJ_GN = PJ_GF + (size_t)NTOK * DM * 2, PJ_END = PJ_GN + (size_t)NTOK * DM * 2;
constexpr size_t WS_OATT = WS_PROJ + PJ_END;
constexpr size_t WS_Y = WS_OATT + (size_t)NTOK * DM * 2;
constexpr size_t WS_WT2 = WS_Y + (size_t)NTOK * DM * 2;
constexpr size_t WS_END = WS_WT2 + (size_t)2 * 2048 * 1024 * 2 + (size_t)2048 * 2048 * 2;
static_assert((size_t)NTOK * FFH * 2 <= PJ_END, "h fits in proj");

struct Params {
  const float* x; const float* n_mix_pre; const float* n_mix_post; const float* n_ffn_pre; const float* n_ffn_post;
  const float* w_in; const float* f_bias; const float* ck_pe; const float* ck_w1; const float* ck_w2;
  const float* cv_pe; const float* cv_w1; const float* cv_w2; const float* w_up_fox; const float* w_up_nsa;
  const float* w_out; const float* w_gate; const float* w_up; const float* w_down;
  float* out; unsigned char* ws;
};

__constant__ float INVF[16] = {1.0f, 0.44036659598350525f, 0.1939227432012558f, 0.08539710193872452f, 0.03760603070259094f, 0.01656043902039528f,
  0.007292664609849453f, 0.0032114458736032248f, 0.0014142135623842478f, 0.000622772378847003f, 0.00027424818836152554f, 0.00012076973507646471f,
  5.318296098266728e-05f, 2.34199997066753e-05f, 1.0313386155758053e-05f, 4.541670477919979e-06f};

__device__ __forceinline__ int launder_v(int x) { asm volatile("" : "+v"(x)); return x; }
__device__ __forceinline__ int launder_s(int x) { asm volatile("" : "+s"(x)); return x; }
#define LAUNDER_IDS const int tix = launder_v((int)threadIdx.x); const int bix = launder_s((int)blockIdx.x); (void)tix; (void)bix;
__device__ __forceinline__ unsigned cvtpk(float lo, float hi) { unsigned r; asm volatile("s_nop 0\n\tv_cvt_pk_bf16_f32 %0, %1, %2" : "=v"(r) : "v"(lo), "v"(hi)); return r; }
__device__ __forceinline__ float bf2f(unsigned short b) { return __uint_as_float(((unsigned)b) << 16); }
__device__ __forceinline__ float bflo(unsigned w) { return __uint_as_float(w << 16); }
__device__ __forceinline__ float bfhi(unsigned w) { return __uint_as_float(w & 0xffff0000u); }
__device__ __forceinline__ float sigmoidf_(float x) { return __builtin_amdgcn_rcpf(1.f + __expf(-x)); }
__device__ __forceinline__ float wave_sum(float v) {
#pragma unroll
  for (int o = 32; o >= 1; o >>= 1) v += __shfl_xor(v, o);
  return v;
}

constexpr int BM = 256, BK = 64, HALF = 128, HTB = HALF * BK * 2, STAGE_BYTES = 8 * HTB, NXCD = 8, WGM = 8;
__device__ __forceinline__ int lds_byte(int r, int c) { const int st = (r >> 4) * 2 + (c >> 5), rr = r & 15, cc = c & 31, ob = rr * 64 + cc * 2; return st * 1024 + (ob ^ (((ob >> 9) & 1) << 5)); }
__device__ __forceinline__ void stage_rc(int b, int& R, int& C) { const int st = b / 1024, sb = b % 1024, swz = sb ^ (((sb >> 9) & 1) << 5); R = (st >> 1) * 16 + swz / 64; C = (st & 1) * 32 + (swz % 64) / 2; }
__device__ __forceinline__ int perm32(int rho) { const int n = rho >> 4, i = rho & 15; return 8 * (i >> 2) + 4 * n + (i & 3); }

struct Unit { int pm, pn, z; };
struct StaticOrder {
  const bf16_t* A; const bf16_t* Bt; int lda, ldb; int nM, nN, nwg, G, c;
  __device__ void init(const bf16_t* A_, const bf16_t* B_, int lda_, int ldb_, int M, int N) {
  LAUNDER_IDS A = A_; Bt = B_; lda = lda_; ldb = ldb_; nM = M / BM; nN = N / BM; nwg = nM * nN; G = gridDim.x; c = bix; }
  __device__ bool next(int i, Unit& u) const {
    const long L = (long)i * G + c; if (L >= nwg) return false;
    int wgid = (int)L; { const int q = nwg / NXCD, r = nwg % NXCD, xcd = wgid % NXCD, off = wgid / NXCD; wgid = (xcd < r ? xcd * (q + 1) : r * (q + 1) + (xcd - r) * q) + off; }
    const int nig = WGM * nN, gid = wgid / nig, fm = gid * WGM, gsz = (nM - fm) < WGM ? (nM - fm) : WGM;
    u.pm = fm + ((wgid % nig) % gsz); u.pn = (wgid % nig) / gsz; u.z = 0; return true;
  }
  __device__ const char* aptr(const Unit& u) const { return (const char*)(A + (size_t)u.pm * BM * lda); }
  __device__ const char* bptr(const Unit& u) const { return (const char*)(Bt + (size_t)u.pn * BM * ldb); }
};
struct CatOrder {
  StaticOrder base; const bf16_t* B1;
  __device__ bool next(int i, Unit& u) const { if (!base.next(i >> 1, u)) return false; u.z = i & 1; return true; }
  __device__ const char* aptr(const Unit& u) const { return (const char*)(base.A + (size_t)u.pm * BM * base.lda + u.z * 1024); }
  __device__ const char* bptr(const Unit& u) const { return (const char*)((u.z ? B1 : base.Bt) + (size_t)u.pn * BM * base.ldb); }
};
struct CmpOrder {
  const bf16_t* A0; const bf16_t* A1; const bf16_t* B0; const bf16_t* B1; int G, c;
  __device__ bool next(int i, Unit& u) const { const int L = i * G + c; if (L >= 256) return false; u.z = (L >> 7) * 16 + (L & 15); u.pm = (L >> 4) & 7; u.pn = 0; return true; }
  __device__ const char* aptr(const Unit& u) const { return (const char*)(((u.z >> 4) ? A1 : A0) + (size_t)u.pm * BM * 2048 + (u.z & 15) * 256); }
  __device__ const char* bptr(const Unit& u) const { return (const char*)(((u.z >> 4) ? B1 : B0) + (u.z & 15) * 256); }
};

template <class Epi, class Sched>
__device__ __forceinline__ void gemm_phase(LAS unsigned char* lds, const int lda, const int ldb, const int K, const Sched& S, const Epi& E) {
  LAUNDER_IDS
  const int tid = tix, wid = __builtin_amdgcn_readfirstlane(tid >> 6), lane = tid & 63, wr = wid >> 2, wc = wid & 3, fr = lane & 15, fq = lane >> 4;
  const int nt = K / BK;
  unsigned voffA[2], voffB[2];
#pragma unroll
  for (int i = 0; i < 2; ++i) { int R, C; stage_rc(tid * 16 + i * 8192, R, C); const int Rb = Epi::PERM ? ((R & ~31) + perm32(R & 31)) : R;
    voffA[i] = (unsigned)(R * lda + C) * 2u; voffB[i] = (unsigned)(Rb * ldb + C) * 2u; }
  const size_t kstep = (size_t)(BK * 2);
  const size_t hstepA = (size_t)HALF * lda * 2, hstepB = (size_t)HALF * ldb * 2;
  const unsigned ldsw = (unsigned)wid * 1024u;
  const int aoff = lds_byte(wr * 64 + fr, fq * 8), boff = lds_byte(wc * 32 + fr, fq * 8);
#define PG8_SA(b, h) (((b) * 2 + (h)) * HTB)
#define PG8_SB(b, h) ((4 + (b) * 2 + (h)) * HTB)
#define PG8_STAGE(bufoff, gbase, voff) do { _Pragma("unroll") for (int _i = 0; _i < 2; ++_i) { unsigned _vo = (voff)[_i]; asm volatile("" : "+v"(_vo)); \
    __builtin_amdgcn_global_load_lds((const unsigned*)((const char*)(gbase) + _vo), (LAS unsigned*)(lds + (bufoff) + ldsw + _i * 8192), 16, 0, 0); } } while (0)
#define PG8_LDA(dst, b, h) do { _Pragma("unroll") for (int m = 0; m < 4; ++m) _Pragma("unroll") for (int k = 0; k < 2; ++k) dst[m][k] = *(const LAS bf16x8*)(lds + PG8_SA(b, h) + aoff + m * 2048 + k * 1024); } while (0)
#define PG8_LDB(dst, b, h) do { _Pragma("unroll") for (int n = 0; n < 2; ++n) _Pragma("unroll") for (int k = 0; k < 2; ++k) dst[n][k] = *(const LAS bf16x8*)(lds + PG8_SB(b, h) + boff + n * 2048 + k * 1024); } while (0)
#define PG8_MMA(ai, bj, At, Bt) do { __builtin_amdgcn_s_setprio(1); _Pragma("unroll") for (int m = 0; m < 4; ++m) _Pragma("unroll") for (int n = 0; n < 2; ++n) _Pragma("unroll") for (int k = 0; k < 2; ++k) \
    acc[ai][bj][m][n] = __builtin_amdgcn_mfma_f32_16x16x32_bf16(Bt[n][k], At[m][k], acc[ai][bj][m][n], 0, 0, 0); __builtin_amdgcn_s_setprio(0); } while (0)
#define PG8_WAIT_V(n) asm volatile("s_waitcnt vmcnt(" #n ")" ::: "memory")
#define PG8_WAIT_L(n) asm volatile("s_waitcnt lgkmcnt(" #n ")" ::: "memory")
#define PG8_BAR __builtin_amdgcn_s_barrier()
#define PG8_SCHED __builtin_amdgcn_sched_barrier(0)
  Unit cur, nxt; int ui = 0;
  if (!S.next(0, cur)) return;
  f32x4 acc[2][2][4][2];
#pragma unroll
  for (int a = 0; a < 2; ++a)
#pragma unroll
    for (int b = 0; b < 2; ++b)
#pragma unroll
      for (int m = 0; m < 4; ++m)
#pragma unroll
        for (int n = 0; n < 2; ++n) acc[a][b][m][n] = (f32x4){0.f, 0.f, 0.f, 0.f};
  bf16x8 At[4][2], B0[2][2], B1[2][2];
  const char* cA = S.aptr(cur); const char* cB = S.bptr(cur);
  PG8_STAGE(PG8_SB(0, 0), cB, voffB); PG8_STAGE(PG8_SB(0, 1), cB + hstepB, voffB); PG8_STAGE(PG8_SA(0, 0), cA, voffA); PG8_STAGE(PG8_SA(0, 1), cA + hstepA, voffA);
  if (wr == 1) PG8_BAR;
  PG8_WAIT_V(2); PG8_BAR;
  PG8_STAGE(PG8_SB(1, 0), cB + kstep, voffB); PG8_STAGE(PG8_SA(1, 0), cA + kstep, voffA); PG8_STAGE(PG8_SB(1, 1), cB + hstepB + kstep, voffB);
  PG8_WAIT_V(6); PG8_BAR;
  for (;;) {
    const bool has_next = S.next(ui + 1, nxt);
    const char* nA = has_next ? S.aptr(nxt) : cA; const char* nB = has_next ? S.bptr(nxt) : cB;
    for (int t = 0; t < nt; t += 2) {
      const bool last = (t == nt - 2);
      const char* a1 = cA + (size_t)(t + 1) * kstep;
      const char* a2 = last ? nA : cA + (size_t)(t + 2) * kstep; const char* b2 = last ? nB : cB + (size_t)(t + 2) * kstep;
      const char* a3 = a2 + kstep; const char* b3 = b2 + kstep;
      PG8_LDB(B0, 0, 0); PG8_LDB(B1, 0, 1); PG8_SCHED; PG8_LDA(At, 0, 0); PG8_STAGE(PG8_SA(1, 1), a1 + hstepA, voffA);
      PG8_WAIT_V(8); PG8_WAIT_L(0); PG8_BAR; PG8_MMA(0, 0, At, B0); PG8_MMA(0, 1, At, B1); PG8_BAR; PG8_SCHED;
      PG8_LDA(At, 0, 1); PG8_STAGE(PG8_SB(0, 0), b2, voffB); PG8_STAGE(PG8_SB(0, 1), b2 + hstepB, voffB); PG8_STAGE(PG8_SA(0, 0), a2, voffA);
      PG8_WAIT_V(8); PG8_WAIT_L(0); PG8_BAR; PG8_MMA(1, 0, At, B0); PG8_MMA(1, 1, At, B1); PG8_BAR; PG8_SCHED;
      PG8_LDB(B0, 1, 0); PG8_LDB(B1, 1, 1); PG8_SCHED; PG8_LDA(At, 1, 0); PG8_STAGE(PG8_SA(0, 1), a2 + hstepA, voffA);
      PG8_WAIT_V(8); PG8_WAIT_L(0); PG8_BAR; PG8_MMA(0, 0, At, B0); PG8_MMA(0, 1, At, B1); PG8_BAR; PG8_SCHED;
      PG8_LDA(At, 1, 1); PG8_STAGE(PG8_SB(1, 0), b3, voffB); PG8_STAGE(PG8_SB(1, 1), b3 + hstepB, voffB); PG8_STAGE(PG8_SA(1, 0), a3, voffA);
      PG8_WAIT_V(8); PG8_WAIT_L(0); PG8_BAR; PG8_MMA(1, 0, At, B0); PG8_MMA(1, 1, At, B1); PG8_BAR; PG8_SCHED;
    }
    if (wr == 0) PG8_BAR;
    bool keep = false;
    if constexpr (Epi::MID) { if (cur.z == 0) { E.mid(acc, cur, wr, wc, fr, fq); keep = true; } else E(acc, cur, wr, wc, fr, fq); } else E(acc, cur, wr, wc, fr, fq);
    if (!has_next) break;
    if (!keep)
#pragma unroll
    for (int a = 0; a < 2; ++a)
#pragma unroll
      for (int b = 0; b < 2; ++b)
#pragma unroll
        for (int m = 0; m < 4; ++m)
#pragma unroll
          for (int n = 0; n < 2; ++n) acc[a][b][m][n] = (f32x4){0.f, 0.f, 0.f, 0.f};
    cur = nxt; cA = nA; cB = nB; ++ui;
    if (wr == 1) PG8_BAR;
  }
  PG8_WAIT_V(0);
  PG8_BAR;
#undef PG8_SA
#undef PG8_SB
#undef PG8_STAGE
#undef PG8_LDA
#undef PG8_LDB
#undef PG8_MMA
#undef PG8_WAIT_V
#undef PG8_WAIT_L
#undef PG8_BAR
#undef PG8_SCHED
}

typedef const f32x4 (&AccRef)[2][2][4][2];
typedef f32x4 (&MutAccRef)[2][2][4][2];

struct EpiIn {
  static constexpr bool PERM = true, MID = false;
  unsigned char* proj; float* small; const float* ropeq;
  __device__ __forceinline__ void operator()(AccRef acc, const Unit& u, int wr, int wc, int fr, int fq) const {
    const int pn = u.pn; const int row0 = u.pm * BM + wr * 64 + fr; const int col8 = wc * 32 + 8 * fq;
    if (pn < 22) {
      const bool rope = (wc == 0) && ((pn >= 12 && pn < 16) || pn == 18 || pn == 20);
      if (rope) {
#pragma unroll
        for (int ai = 0; ai < 2; ++ai) {
          f32x4 cs[4][2], sn[4][2];
#pragma unroll
          for (int m = 0; m < 4; ++m) { const int t = (row0 + ai * HALF + m * 16) & 4095; const float* rc = ropeq + t * 16 + 8 * (fq & 1);
            cs[m][0] = *(const f32x4*)rc; cs[m][1] = *(const f32x4*)(rc + 4); sn[m][0] = *(const f32x4*)(rc + 65536); sn[m][1] = *(const f32x4*)(rc + 65536 + 4); }
#pragma unroll
          for (int m = 0; m < 4; ++m) {
            const int row = row0 + ai * HALF + m * 16; const int b = row >> 12, t = row & 4095;
#pragma unroll
            for (int bj = 0; bj < 2; ++bj) {
              f32x4 v0 = acc[ai][bj][m][0], v1 = acc[ai][bj][m][1];
              f32x4 p0, p1;
#pragma unroll
              for (int j = 0; j < 4; ++j) { p0[j] = __shfl_xor(v0[j], 32); p1[j] = __shfl_xor(v1[j], 32); }
              const float sg = (fq < 2) ? -1.f : 1.f;
#pragma unroll
              for (int j = 0; j < 4; ++j) { v0[j] = v0[j] * cs[m][0][j] + sg * p0[j] * sn[m][0][j]; v1[j] = v1[j] * cs[m][1][j] + sg * p1[j] * sn[m][1][j]; }
              bf16_t* dst;
              if (pn < 16) { const int head = (pn & 3) * 2 + bj; dst = (bf16_t*)(proj + (size_t)(pn >> 2) * SZ_HM) + ((size_t)(b * 8 + head) * 4096 + t) * 128 + col8; }
              else { dst = (bf16_t*)(proj + PJ_KV + (size_t)(pn - 16) * SZ_KV) + ((size_t)(b * 2 + bj) * 4096 + t) * 128 + col8; }
              u32x4 w; w.x = cvtpk(v0[0], v0[1]); w.y = cvtpk(v0[2], v0[3]); w.z = cvtpk(v1[0], v1[1]); w.w = cvtpk(v1[2], v1[3]);
              *(u32x4*)dst = w;
            }
          }
        }
      } else {
#pragma unroll
        for (int ai = 0; ai < 2; ++ai)
#pragma unroll
          for (int m = 0; m < 4; ++m) {
            const int row = row0 + ai * HALF + m * 16; const int b = row >> 12, t = row & 4095;
#pragma unroll
            for (int bj = 0; bj < 2; ++bj) {
              const f32x4 v0 = acc[ai][bj][m][0], v1 = acc[ai][bj][m][1];
              bf16_t* dst;
              if (pn < 16) { const int head = (pn & 3) * 2 + bj; dst = (bf16_t*)(proj + (size_t)(pn >> 2) * SZ_HM) + ((size_t)(b * 8 + head) * 4096 + t) * 128 + col8; }
              else { dst = (bf16_t*)(proj + PJ_KV + (size_t)(pn - 16) * SZ_KV) + ((size_t)(b * 2 + bj) * 4096 + t) * 128 + col8; }
              u32x4 w; w.x = cvtpk(v0[0], v0[1]); w.y = cvtpk(v0[2], v0[3]); w.z = cvtpk(v1[0], v1[1]); w.w = cvtpk(v1[2], v1[3]);
              *(u32x4*)dst = w;
            }
          }
      }
    } else if (pn < 38) {
      bf16_t* gb = (bf16_t*)(proj + (pn < 30 ? PJ_GF : PJ_GN)); const int colt = ((pn - 22) & 7) * 256 + col8;
#pragma unroll
      for (int ai = 0; ai < 2; ++ai)
#pragma unroll
        for (int m = 0; m < 4; ++m) {
          const int row = row0 + ai * HALF + m * 16;
#pragma unroll
          for (int bj = 0; bj < 2; ++bj) {
            f32x4 v0 = acc[ai][bj][m][0], v1 = acc[ai][bj][m][1];
#pragma unroll
            for (int j = 0; j < 4; ++j) { v0[j] = sigmoidf_(v0[j]); v1[j] = sigmoidf_(v1[j]); }
            u32x4 w; w.x = cvtpk(v0[0], v0[1]); w.y = cvtpk(v0[2], v0[3]); w.z = cvtpk(v1[0], v1[1]); w.w = cvtpk(v1[2], v1[3]);
            *(u32x4*)(gb + (size_t)row * DM + colt + bj * HALF) = w;
          }
        }
    } else {
      if (wc == 0) {
#pragma unroll
        for (int ai = 0; ai < 2; ++ai)
#pragma unroll
          for (int m = 0; m < 4; ++m) {
            const int row = row0 + ai * HALF + m * 16;
            float* d = small + (size_t)row * 32 + 8 * fq;
            *(f32x4*)d = acc[ai][0][m][0]; *(f32x4*)(d + 4) = acc[ai][0][m][1];
          }
      }
    }
  }
};

struct EpiPartial {
  static constexpr bool PERM = true, MID = false;
  bf16_t* out;
  __device__ __forceinline__ void operator()(AccRef acc, const Unit& u, int wr, int wc, int fr, int fq) const {
    const int row0 = u.pm * BM + wr * 64 + fr, col0 = wc * 32 + 8 * fq;
    bf16_t* base = out + (size_t)u.z * 2048 * 256;
#pragma unroll
    for (int ai = 0; ai < 2; ++ai)
#pragma unroll
      for (int m = 0; m < 4; ++m) { bf16_t* rowp = base + (size_t)(row0 + ai * HALF + m * 16) * 256 + col0;
#pragma unroll
        for (int bj = 0; bj < 2; ++bj) { const f32x4 v0 = acc[ai][bj][m][0], v1 = acc[ai][bj][m][1];
          u32x4 w; w.x = cvtpk(v0[0], v0[1]); w.y = cvtpk(v0[2], v0[3]); w.z = cvtpk(v1[0], v1[1]); w.w = cvtpk(v1[2], v1[3]);
          *(u32x4*)(rowp + bj * HALF) = w; } }
  }
};

struct EpiUpCat {
  static constexpr bool PERM = true, MID = true;
  const bf16_t* gf; const bf16_t* gn; bf16_t* mix;
  __device__ __forceinline__ void mid(MutAccRef acc, const Unit& u, int wr, int wc, int fr, int fq) const {
    const int row0 = u.pm * BM + wr * 64 + fr; const int col0 = u.pn * BM + wc * 32 + 8 * fq;
#pragma unroll
    for (int ai = 0; ai < 2; ++ai) {
      u32x4 a[4][2], b[4][2];
#pragma unroll
      for (int m = 0; m < 4; ++m)
#pragma unroll
        for (int bj = 0; bj < 2; ++bj) { const size_t ro = (size_t)(row0 + ai * HALF + m * 16) * DM + col0 + bj * HALF; a[m][bj] = *(const u32x4*)(gf + ro); b[m][bj] = *(const u32x4*)(gn + ro); }
#pragma unroll
      for (int m = 0; m < 4; ++m)
#pragma unroll
        for (int bj = 0; bj < 2; ++bj) { const u32x4 x = a[m][bj], y = b[m][bj];
          acc[ai][bj][m][0][0] *= bflo(x.x) * __builtin_amdgcn_rcpf(bflo(y.x)); acc[ai][bj][m][0][1] *= bfhi(x.x) * __builtin_amdgcn_rcpf(bfhi(y.x));
          acc[ai][bj][m][0][2] *= bflo(x.y) * __builtin_amdgcn_rcpf(bflo(y.y)); acc[ai][bj][m][0][3] *= bfhi(x.y) * __builtin_amdgcn_rcpf(bfhi(y.y));
          acc[ai][bj][m][1][0] *= bflo(x.z) * __builtin_amdgcn_rcpf(bflo(y.z)); acc[ai][bj][m][1][1] *= bfhi(x.z) * __builtin_amdgcn_rcpf(bfhi(y.z));
          acc[ai][bj][m][1][2] *= bflo(x.w) * __builtin_amdgcn_rcpf(bflo(y.w)); acc[ai][bj][m][1][3] *= bfhi(x.w) * __builtin_amdgcn_rcpf(bfhi(y.w)); }
    }
  }
  __device__ __forceinline__ void operator()(AccRef acc, const Unit& u, int wr, int wc, int fr, int fq) const {
    const int row0 = u.pm * BM + wr * 64 + fr; const int col0 = u.pn * BM + wc * 32 + 8 * fq;
#pragma unroll
    for (int ai = 0; ai < 2; ++ai) {
      u32x4 b[4][2];
#pragma unroll
      for (int m = 0; m < 4; ++m)
#pragma unroll
        for (int bj = 0; bj < 2; ++bj) { const size_t ro = (size_t)(row0 + ai * HALF + m * 16) * DM + col0 + bj * HALF; b[m][bj] = *(const u32x4*)(gn + ro); }
#pragma unroll
      for (int m = 0; m < 4; ++m)
#pragma unroll
        for (int bj = 0; bj < 2; ++bj) { const size_t ro = (size_t)(row0 + ai * HALF + m * 16) * DM + col0 + bj * HALF; const u32x4 y = b[m][bj];
          const f32x4 v0 = acc[ai][bj][m][0], v1 = acc[ai][bj][m][1];
          u32x4 w; w.x = cvtpk(v0[0] * bflo(y.x), v0[1] * bfhi(y.x)); w.y = cvtpk(v0[2] * bflo(y.y), v0[3] * bfhi(y.y)); w.z = cvtpk(v1[0] * bflo(y.z), v1[1] * bfhi(y.z)); w.w = cvtpk(v1[2] * bflo(y.w), v1[3] * bfhi(y.w));
          *(u32x4*)(mix + ro) = w; }
    }
  }
};

struct EpiY {
  static constexpr bool PERM = true, MID = false;
  bf16_t* y; float* ssq;
  __device__ __forceinline__ void operator()(AccRef acc, const Unit& u, int wr, int wc, int fr, int fq) const {
    const int row0 = u.pm * BM + wr * 64 + fr; const int col0 = u.pn * BM + wc * 32 + 8 * fq;
#pragma unroll
    for (int ai = 0; ai < 2; ++ai)
#pragma unroll
      for (int m = 0; m < 4; ++m) {
        const int row = row0 + ai * HALF + m * 16; float s = 0.f;
#pragma unroll
        for (int bj = 0; bj < 2; ++bj) {
          const f32x4 v0 = acc[ai][bj][m][0], v1 = acc[ai][bj][m][1];
#pragma unroll
          for (int j = 0; j < 4; ++j) s += v0[j] * v0[j] + v1[j] * v1[j];
          u32x4 w; w.x = cvtpk(v0[0], v0[1]); w.y = cvtpk(v0[2], v0[3]); w.z = cvtpk(v1[0], v1[1]); w.w = cvtpk(v1[2], v1[3]);
          *(u32x4*)(y + (size_t)row * DM + col0 + bj * HALF) = w;
        }
        s += __shfl_xor(s, 16); s += __shfl_xor(s, 32);
        if (fq == 0) ssq[(size_t)row * 32 + u.pn * 4 + wc] = s;
      }
  }
};

struct EpiSwiglu {
  static constexpr bool PERM = true, MID = false;
  bf16_t* h;
  __device__ __forceinline__ void operator()(AccRef acc, const Unit& u, int wr, int wc, int fr, int fq) const {
    const int row0 = u.pm * BM + wr * 64 + fr; const int col0 = u.pn * HALF + wc * 32 + 8 * fq;
#pragma unroll
    for (int ai = 0; ai < 2; ++ai)
#pragma unroll
      for (int m = 0; m < 4; ++m) {
        const int row = row0 + ai * HALF + m * 16;
        float r[8];
#pragma unroll
        for (int n = 0; n < 2; ++n)
#pragma unroll
          for (int j = 0; j < 4; ++j) { const float g = acc[ai][0][m][n][j], up = acc[ai][1][m][n][j]; r[n * 4 + j] = g * sigmoidf_(g) * up; }
        u32x4 w; w.x = cvtpk(r[0], r[1]); w.y = cvtpk(r[2], r[3]); w.z = cvtpk(r[4], r[5]); w.w = cvtpk(r[6], r[7]);
        *(u32x4*)(h + (size_t)row * FFH + col0) = w;
      }
  }
};

__device__ __forceinline__ int inmap(int n) {
  if (n < 3072) return n;
  if (n < 4096) return n + 8;
  if (n < 5632) return n + 8;
  if (n < 9728) return n + 32;
  if (n < 9736) return n - 9728 + 3072;
  if (n < 9760) return n - 9736 + 5640;
  return -1;
}
template <int MAP>
__device__ __forceinline__ void conv_tile(const float* src, int ld, const float* src2, bf16_t* dst, int K, int n0, int k0, float* tl) {
  LAUNDER_IDS
  const int tid = tix;
  { const int r = tid >> 4, c4 = (tid & 15) * 4;
    f32x4 v[4][2];
#pragma unroll
    for (int cg = 0; cg < 4; ++cg) {
      const int n = n0 + cg * 64 + c4; const float* s = src; int sc;
      if (MAP == 1) sc = inmap(n);
      else if (MAP == 2) { const int j = n >> 8, w = n & 255; if (w < 128) { sc = j * 128 + w; } else { sc = j * 128 + w - 128; s = src2; } }
      else sc = n;
#pragma unroll
      for (int h = 0; h < 2; ++h) { v[cg][h] = (f32x4){0.f, 0.f, 0.f, 0.f}; if (sc >= 0) v[cg][h] = *(const f32x4*)(s + (size_t)(k0 + r + h * 32) * ld + sc); }
    }
#pragma unroll
    for (int cg = 0; cg < 4; ++cg)
#pragma unroll
      for (int h = 0; h < 2; ++h) { float* d = tl + (r + h * 32) * 257 + cg * 64 + c4; d[0] = v[cg][h][0]; d[1] = v[cg][h][1]; d[2] = v[cg][h][2]; d[3] = v[cg][h][3]; }
  }
  __syncthreads();
#pragma unroll
  for (int it = 0; it < 4; ++it) { const int idx = it * NTHR + tid, q = idx & 7, n = idx >> 3;
    float v[8];
#pragma unroll
    for (int j = 0; j < 8; ++j) v[j] = tl[(q * 8 + j) * 257 + n];
    u32x4 w; w.x = cvtpk(v[0], v[1]); w.y = cvtpk(v[2], v[3]); w.z = cvtpk(v[4], v[5]); w.w = cvtpk(v[6], v[7]);
    *(u32x4*)(dst + (size_t)(n0 + n) * K + k0 + q * 8) = w;
  }
  __syncthreads();
}
__device__ __forceinline__ void convert_mixer(const Params& p, int l, float* tl) {
  LAUNDER_IDS
  unsigned char* wt = p.ws + WS_WT;
  const float* w_in = p.w_in + (size_t)l * DM * INW;
  const float* wuf = p.w_up_fox + (size_t)l * 1024 * DM; const float* wun = p.w_up_nsa + (size_t)l * 1024 * DM;
  const float* wo = p.w_out + (size_t)l * DM * DM;
  const float* c1k = p.ck_w1 + (size_t)l * 4096 * 256; const float* c1v = p.cv_w1 + (size_t)l * 4096 * 256;
  constexpr int T_IN = 32 * 39, T_UP = 16 * 8, T_OUT = 32 * 8, T_C1 = 64;
  constexpr int TOTAL = T_IN + 2 * T_UP + T_OUT + 2 * T_C1;
  for (int j = bix; j < TOTAL; j += gridDim.x) {
    int q = j;
    if (q < T_IN) { conv_tile<1>(w_in, INW, nullptr, (bf16_t*)(wt + WT_IN), DM, (q / 32) * 256, (q % 32) * 64, tl); continue; } q -= T_IN;
    if (q < T_UP) { conv_tile<0>(wuf, DM, nullptr, (bf16_t*)(p.ws + WS_WT2 + W2_UPF), 1024, (q / 16) * 256, (q % 16) * 64, tl); continue; } q -= T_UP;
    if (q < T_UP) { conv_tile<0>(wun, DM, nullptr, (bf16_t*)(p.ws + WS_WT2 + W2_UPN), 1024, (q / 16) * 256, (q % 16) * 64, tl); continue; } q -= T_UP;
    if (q < T_OUT) { conv_tile<0>(wo, DM, nullptr, (bf16_t*)(p.ws + WS_WT2 + W2_OUT), DM, (q / 32) * 256, (q % 32) * 64, tl); continue; } q -= T_OUT;
    if (q < T_C1) { conv_tile<0>(c1k, 256, nullptr, (bf16_t*)(wt + WT_C1K), 4096, 0, q * 64, tl); continue; } q -= T_C1;
    conv_tile<0>(c1v, 256, nullptr, (bf16_t*)(wt + WT_C1V), 4096, 0, q * 64, tl);
  }
  float* peb = (float*)(p.ws + WS_PEB);
  for (int j = bix; j < 64; j += gridDim.x) {
    const int mat = j >> 5, sl = j & 31; const float* pe = (mat ? p.cv_pe : p.ck_pe) + (size_t)l * 4096 + sl * 128; const float* w1 = (mat ? c1v : c1k) + (size_t)sl * 128 * 256;
    if (tix < 256) { float s = 0.f;
#pragma unroll 8
      for (int kk = 0; kk < 128; ++kk) s += pe[kk] * w1[kk * 256 + tix]; peb[(mat * 32 + sl) * 256 + tix] = s; }
  }
}
constexpr int T_FFN_GU = 32 * 44, T_FFN_DN = 88 * 8, T_FFN = T_FFN_GU + T_FFN_DN;
__device__ __forceinline__ void convert_ffn_tile(const Params& p, int l, int j, float* tl) {
  unsigned char* wt = p.ws + WS_WT;
  const float* wg = p.w_gate + (size_t)l * DM * FFH; const float* wu = p.w_up + (size_t)l * DM * FFH; const float* wd = p.w_down + (size_t)l * FFH * DM;
  if (j < T_FFN_GU) conv_tile<2>(wg, FFH, wu, (bf16_t*)(wt + WT_GU), DM, (j / 32) * 256, (j % 32) * 64, tl);
  else { const int q = j - T_FFN_GU; conv_tile<0>(wd, DM, nullptr, (bf16_t*)(wt + WT_DOWN), FFH, (q / 88) * 256, (q % 88) * 64, tl); }
}

__device__ __forceinline__ void row_phase(int mode, const float* xin, float* xout, const bf16_t* __restrict__ y, const float* __restrict__ ssq, const float* __restrict__ g_post, const float* __restrict__ g_next, bf16_t* __restrict__ abuf) {
  LAUNDER_IDS
  const int lane = tix & 63, gw = (bix & 7) * 2048 + (bix >> 3) * 8 + (tix >> 6);
  for (int row = gw; row < gw + 2048; row += 256) {
    f32x4 v[8];
    const float* xr = xin + (size_t)row * DM;
#pragma unroll
    for (int i = 0; i < 8; ++i) v[i] = *(const f32x4*)(xr + (i * 64 + lane) * 4);
    if (mode == 1) {
      u32x2 yy[8]; f32x4 g[8];
      const bf16_t* yr = y + (size_t)row * DM;
      float sp = (lane < 32) ? ssq[(size_t)row * 32 + lane] : 0.f;
#pragma unroll
      for (int i = 0; i < 8; ++i) { const int c = (i * 64 + lane) * 4; yy[i] = *(const u32x2*)(yr + c); g[i] = *(const f32x4*)(g_post + c); }
      sp = wave_sum(sp);
      const float rs = rsqrtf(sp * (1.f / DM) + EPSN);
#pragma unroll
      for (int i = 0; i < 8; ++i) {
        v[i][0] += bflo(yy[i].x) * rs * g[i][0]; v[i][1] += bfhi(yy[i].x) * rs * g[i][1]; v[i][2] += bflo(yy[i].y) * rs * g[i][2]; v[i][3] += bfhi(yy[i].y) * rs * g[i][3]; }
#pragma unroll
      for (int i = 0; i < 8; ++i) *(f32x4*)(xout + (size_t)row * DM + (i * 64 + lane) * 4) = v[i];
    }
    if (g_next) {
      f32x4 g[8];
#pragma unroll
      for (int i = 0; i < 8; ++i) g[i] = *(const f32x4*)(g_next + (i * 64 + lane) * 4);
      float s = 0.f;
#pragma unroll
      for (int i = 0; i < 8; ++i) s += v[i][0] * v[i][0] + v[i][1] * v[i][1] + v[i][2] * v[i][2] + v[i][3] * v[i][3];
      s = wave_sum(s);
      const float rs = rsqrtf(s * (1.f / DM) + EPSN);
#pragma unroll
      for (int i = 0; i < 8; ++i) { const int c = (i * 64 + lane) * 4;
        u32x2 w; w.x = cvtpk(v[i][0] * rs * g[i][0], v[i][1] * rs * g[i][1]); w.y = cvtpk(v[i][2] * rs * g[i][2], v[i][3] * rs * g[i][3]);
        *(u32x2*)(abuf + (size_t)row * DM + c) = w; }
    }
  }
}

__device__ __forceinline__ void sincos_d(float ang, float& c, float& s) {
  const double x = (double)ang; const double q = rint(x * 0.63661977236758134308);
  double r = fma(-q, 1.57079632679489655800e+00, x); r = fma(-q, 6.12323399573676603587e-17, r);
  const int qi = (int)q; const double r2 = r * r;
  const double sr = r * (1.0 + r2 * (-1.0 / 6 + r2 * (1.0 / 120 + r2 * (-1.0 / 5040 + r2 * (1.0 / 362880 + r2 * (-1.0 / 39916800 + r2 * (1.0 / 6227020800.0)))))));
  const double cr = 1.0 + r2 * (-0.5 + r2 * (1.0 / 24 + r2 * (-1.0 / 720 + r2 * (1.0 / 40320 + r2 * (-1.0 / 3628800 + r2 * (1.0 / 479001600 + r2 * (-1.0 / 87178291200.0)))))));
  double cc, ss;
  switch (qi & 3) { case 0: cc = cr; ss = sr; break; case 1: cc = -sr; ss = cr; break; case 2: cc = -cr; ss = -sr; break; default: cc = sr; ss = -cr; break; }
  c = (float)cc; s = (float)ss;
}
__device__ __forceinline__ void rope_tables(const Params& p) {
  LAUNDER_IDS
  float* rq = (float*)(p.ws + WS_ROPEQ); float* rc = (float*)(p.ws + WS_ROPEC);
  for (int e = bix * NTHR + tix; e < 65536 + 4096; e += gridDim.x * NTHR) {
    if (e < 65536) { const int t = e >> 4, i = e & 15; float c, s; sincos_d((float)t * INVF[i], c, s); rq[e] = c; rq[65536 + e] = s; }
    else { const int e2 = e - 65536, n = e2 >> 4, i = e2 & 15; float c, s; sincos_d((float)(n * 16 + 31) * INVF[i], c, s); rc[e2] = c; rc[4096 + e2] = s; }
  }
}
__device__ __forceinline__ int item_cost(int id) {
  if (id < 512) return 4 * ((id & 15) + 1);
  const int c = (id - 512) & 63; return (c + 1) + (c + 1 < 9 ? c + 1 : 9) + 2 * ((4 * c + 2) / 64 + 1) + 4;
}
__device__ __forceinline__ void sort_items(const Params& p, int* lc) {
  LAUNDER_IDS
  int* order = (int*)(p.ws + WS_ORDER);
  for (int id = tix; id < 1024; id += NTHR) lc[id] = item_cost(id);
  __syncthreads();
  for (int id = tix; id < 1024; id += NTHR) {
    const int mc = lc[id]; int rank = 0;
    for (int o = 0; o < 1024; ++o) { const int oc = lc[o]; rank += (oc > mc) || (oc == mc && o < id); }
    order[rank] = id;
  }
  if (tix < 8) ((unsigned*)(p.ws + WS_CTL))[tix] = 0u;
  if (tix < 64) ((unsigned*)(p.ws + WS_CTL + 256))[tix] = 0u;
  for (int i = tix; i < 4096; i += NTHR) ((unsigned*)(p.ws + WS_BAR))[i] = 0u;
  __syncthreads();
}

__device__ __forceinline__ void cumsum_phase(const Params& p, int l, float* lf) {
  LAUNDER_IDS
  if (bix >= 32) return;
  const int bh = bix, b = bh >> 3, h = bh & 7, lane = tix & 63, w = tix >> 6;
  const float* sm = (const float*)(p.ws + WS_SMALL) + ((size_t)b * 4096 + tix * 8) * 32 + h; const float fb = p.f_bias[l * 8 + h];
  float* cum = (float*)(p.ws + WS_CUM) + bh * 4096 + tix * 8;
  float x[8], v[8]; float run = 0.f;
#pragma unroll
  for (int j = 0; j < 8; ++j) x[j] = sm[j * 32] + fb;
#pragma unroll
  for (int j = 0; j < 8; ++j) { run += fminf(x[j], 0.f) - log1pf(__expf(-fabsf(x[j]))); v[j] = run; }
  float inc = run;
#pragma unroll
  for (int o = 1; o < 64; o <<= 1) { const float n = __shfl_up(inc, o); if (lane >= o) inc += n; }
  if (lane == 63) lf[w] = inc;
  __syncthreads();
  float base = inc - run;
  for (int i = 0; i < w; ++i) base += lf[i];
#pragma unroll
  for (int j = 0; j < 8; ++j) cum[j] = base + v[j];
  __syncthreads();
}

__device__ __forceinline__ void kmax_phase(const Params& p, int l) {
  LAUNDER_IDS
  if (bix < 32 || bix >= 160) return;
  const int part = bix - 32, bh = part >> 2, q4 = part & 3;
  const bf16_t* K = (const bf16_t*)(p.ws + WS_PROJ + PJ_FK) + ((size_t)bh * 4096 + q4 * 1024) * 128;
  float mx = 0.f;
#pragma unroll 8
  for (int it = 0; it < 32; ++it) { const int idx = it * NTHR + tix;
    const u32x4 v = *(const u32x4*)(K + (size_t)idx * 8);
    float s = bflo(v.x) * bflo(v.x) + bfhi(v.x) * bfhi(v.x) + bflo(v.y) * bflo(v.y) + bfhi(v.y) * bfhi(v.y) + bflo(v.z) * bflo(v.z) + bfhi(v.z) * bfhi(v.z) + bflo(v.w) * bflo(v.w) + bfhi(v.w) * bfhi(v.w);
    s += __shfl_xor(s, 1); s += __shfl_xor(s, 2); s += __shfl_xor(s, 4); s += __shfl_xor(s, 8);
    mx = fmaxf(mx, s); }
#pragma unroll
  for (int o = 32; o >= 1; o >>= 1) mx = fmaxf(mx, __shfl_xor(mx, o));
  if ((tix & 63) == 0) atomicMax((unsigned*)(p.ws + WS_CTL + 256) + l * 32 + bh, __float_as_uint(mx));
}

__device__ __forceinline__ void cmp_finish(const Params& p, int l, float* lf) {
  LAUNDER_IDS
  float* pebs = lf;
  float* hs = lf + 256;
  float* os = lf + 256 + 4096;
  bf16_t* w2s = (bf16_t*)(lf + 256 + 4096 + 2048);
  const bf16_t* part = (const bf16_t*)(p.ws + WS_Y); const float* peb = (const float*)(p.ws + WS_PEB); const float* rc = (const float*)(p.ws + WS_ROPEC);
  const int tid = tix;
  for (int task = bix; task < 256; task += gridDim.x) {
    const int mat = task >> 7, R0 = (task & 127) * 16;
    { const float* w2 = (mat ? p.cv_w2 : p.ck_w2) + (size_t)l * 256 * 128;
      f32x4 w[16];
#pragma unroll
      for (int i = 0; i < 16; ++i) w[i] = *(const f32x4*)(w2 + (i * NTHR + tid) * 4);
#pragma unroll
      for (int i = 0; i < 16; ++i) { u32x2 q; q.x = cvtpk(w[i][0], w[i][1]); q.y = cvtpk(w[i][2], w[i][3]); *(u32x2*)(w2s + (i * NTHR + tid) * 4) = q; } }
    if (tid < 256) { float sl[32];
#pragma unroll
      for (int i = 0; i < 32; ++i) sl[i] = peb[(mat * 32 + i) * 256 + tid];
      float s = 0.f;
#pragma unroll
      for (int i = 0; i < 32; ++i) s += sl[i];
      pebs[tid] = s; }
    __syncthreads();
    { const int r = tid >> 5, c = (tid & 31) * 8; u32x4 q[16];
#pragma unroll
      for (int sp = 0; sp < 16; ++sp) q[sp] = *(const u32x4*)(part + ((size_t)(mat * 16 + sp) * 2048 + R0 + r) * 256 + c);
      float a[8] = {0.f, 0.f, 0.f, 0.f, 0.f, 0.f, 0.f, 0.f};
#pragma unroll
      for (int sp = 0; sp < 16; ++sp) { a[0] += bflo(q[sp].x); a[1] += bfhi(q[sp].x); a[2] += bflo(q[sp].y); a[3] += bfhi(q[sp].y); a[4] += bflo(q[sp].z); a[5] += bfhi(q[sp].z); a[6] += bflo(q[sp].w); a[7] += bfhi(q[sp].w); }
#pragma unroll
      for (int j = 0; j < 8; ++j) { const float x = a[j] + pebs[c + j]; const float u = 0.7978845608028654f * (x + 0.044715f * x * x * x);
        const float th = 1.f - 2.f * __builtin_amdgcn_rcpf(1.f + __expf(2.f * u)); hs[r * 256 + c + j] = 0.5f * x * (1.f + th); } }
    __syncthreads();
    const int r = tid >> 5, n4 = (tid & 31) * 4;
    { f32x4 a = (f32x4){0.f, 0.f, 0.f, 0.f};
#pragma unroll 8
      for (int k = 0; k < 256; ++k) { const float hv = hs[r * 256 + k]; const u32x2 w = *(const u32x2*)(w2s + k * 128 + n4);
        a[0] += hv * bflo(w.x); a[1] += hv * bfhi(w.x); a[2] += hv * bflo(w.y); a[3] += hv * bfhi(w.y); }
      *(f32x4*)(os + r * 128 + n4) = a; }
    __syncthreads();
    { const int R = R0 + r, i = R & 255;
      f32x4 v = *(const f32x4*)(os + r * 128 + n4);
      if (mat == 0 && n4 < 32) { const int f = n4 & 15; const f32x4 cc = *(const f32x4*)(rc + i * 16 + f), ss = *(const f32x4*)(rc + 4096 + i * 16 + f);
        if (n4 < 16) { const f32x4 q = *(const f32x4*)(os + r * 128 + n4 + 16); v = v * cc - q * ss; }
        else { const f32x4 q = *(const f32x4*)(os + r * 128 + n4 - 16); v = v * cc + q * ss; } }
      if (i == 255) v = (f32x4){0.f, 0.f, 0.f, 0.f};
      u32x2 w; w.x = cvtpk(v[0], v[1]); w.y = cvtpk(v[2], v[3]);
      *(u32x2*)((bf16_t*)(p.ws + (mat ? WS_VC : WS_KC)) + (size_t)R * 128 + n4) = w; }
    __syncthreads();
  }
}

constexpr int SHM_V = 64 * 128 * 2, SHM_K = 64 * 128 * 2;
constexpr int AT_SCR = 2 * SHM_V + 2 * SHM_K;
constexpr int AT_CB = AT_SCR + 8 * 64 * 4;
constexpr int AT_IMPU = AT_CB + 2 * 64 * 4;
constexpr int AT_IMPW = AT_IMPU + 8 * 8 * 64 * 4;
constexpr int AT_Q = AT_IMPW + 8 * 8 * 64 * 4;
constexpr int AT_END = AT_Q + 128;
#define KSWZ(row, colB) ((row) * 256 + ((colB) ^ (((row) & 7) << 4)))
#define SBAR() __builtin_amdgcn_sched_barrier(0)
__device__ __forceinline__ int v_st(int k, int c) { const int kk = (k & ~0xC) | ((k & 4) << 1) | ((k & 8) >> 1); return ((kk >> 3) * 4 + (c >> 5)) * 512 + ((kk & 7) * 32 + (c & 31)) * 2; }
__device__ __forceinline__ int v_rd_base(int lane) { return ((lane & 3) << 3) | (((lane >> 2) & 3) << 6) | (((lane >> 4) & 1) << 5) | (((lane >> 5) & 1) << 8); }
constexpr int v_rd_off(int d0, int ks, int half) { return d0 * 512 + ks * 4096 + half * 2048; }
__device__ __forceinline__ int crow(int r, int hi) { return (r & 3) + 8 * (r >> 2) + 4 * hi; }

__device__ __forceinline__ void mask_tile(f32x16& p0, f32x16& p1, int dq, unsigned W) {
  const float NEG = -__builtin_inff();
#pragma unroll
  for (int r = 0; r < 16; ++r) {
    const int c = (r & 3) + 8 * (r >> 2);
    if ((unsigned)(dq - c) >= W) p0[r] = NEG;
    if ((unsigned)(dq - c - 32) >= W) p1[r] = NEG;
  }
}
__device__ __forceinline__ void partialSM(f32x16& p0, f32x16& p1, float& m_reg, float& alpha) {
  float pmax = p0[0];
#pragma unroll
  for (int r = 1; r < 16; ++r) pmax = fmaxf(pmax, p0[r]);
#pragma unroll
  for (int r = 0; r < 16; ++r) pmax = fmaxf(pmax, p1[r]);
  { auto rr = __builtin_amdgcn_permlane32_swap(__float_as_uint(pmax), __float_as_uint(pmax), false, false);
    pmax = fmaxf(__uint_as_float(rr[0]), __uint_as_float(rr[1])); }
  float mn;
  if (__all((pmax - m_reg) <= 11.5f)) { mn = m_reg; alpha = 1.f; }
  else { mn = fmaxf(m_reg, pmax); alpha = __builtin_amdgcn_exp2f(m_reg - mn); m_reg = mn; }
#pragma unroll
  for (int r = 0; r < 16; ++r) p0[r] = __builtin_amdgcn_exp2f(p0[r] - mn);
#pragma unroll
  for (int r = 0; r < 16; ++r) p1[r] = __builtin_amdgcn_exp2f(p1[r] - mn);
}
__device__ __forceinline__ void finishSM(f32x16& p0, f32x16& p1, float alpha, float& l_reg, bf16x8& pa0, bf16x8& pa1, bf16x8& pa2, bf16x8& pa3) {
  float ps = 0;
#pragma unroll
  for (int r = 0; r < 16; ++r) ps += p0[r];
#pragma unroll
  for (int r = 0; r < 16; ++r) ps += p1[r];
  { auto rr = __builtin_amdgcn_permlane32_swap(__float_as_uint(ps), __float_as_uint(ps), false, false);
    ps = __uint_as_float(rr[0]) + __uint_as_float(rr[1]); }
  l_reg = l_reg * alpha + ps;
#define PK4(P, B_, OUT) do { unsigned a0 = cvtpk(P[B_+0], P[B_+1]), a1 = cvtpk(P[B_+2], P[B_+3]);                          \
    unsigned b0 = cvtpk(P[B_+4], P[B_+5]), b1 = cvtpk(P[B_+6], P[B_+7]);                                             \
    auto r0 = __builtin_amdgcn_permlane32_swap(a0, b0, false, false); auto r1 = __builtin_amdgcn_permlane32_swap(a1, b1, false, false); \
    u32x4 w = {r0[0], r1[0], r0[1], r1[1]}; OUT = *reinterpret_cast<bf16x8*>(&w); } while (0)
  PK4(p0, 0, pa0); PK4(p0, 8, pa1); PK4(p1, 0, pa2); PK4(p1, 8, pa3);
#undef PK4
}
template <int MODE>
__device__ __forceinline__ bool partialSM3(f32x16& p0, f32x16& p1, float& m_reg, float& alpha, bool rsel) {
  float pmax = p0[0];
#pragma unroll
  for (int r = 1; r < 16; ++r) pmax = fmaxf(pmax, p0[r]);
#pragma unroll
  for (int r = 0; r < 16; ++r) pmax = fmaxf(pmax, p1[r]);
  { auto rr = __builtin_amdgcn_permlane32_swap(__float_as_uint(pmax), __float_as_uint(pmax), false, false);
    pmax = fmaxf(__uint_as_float(rr[0]), __uint_as_float(rr[1])); }
  if (MODE != 0) pmax *= C2;
  if (MODE == 3 && !rsel) pmax = -__builtin_inff();
  if (MODE == 0) { if (__all(pmax - m_reg < -160.f)) { alpha = 1.f; return true; } }
  float mn;
  if (__all((pmax - m_reg) <= 11.5f)) { mn = m_reg; alpha = 1.f; }
  else { mn = fmaxf(m_reg, pmax); alpha = __builtin_amdgcn_exp2f(m_reg - mn); m_reg = mn; }
  float mnL = -mn;
  if (MODE == 3 && !rsel) mnL = -__builtin_inff();
  if (MODE == 0) {
#pragma unroll
    for (int r = 0; r < 16; ++r) { p0[r] = __builtin_amdgcn_exp2f(p0[r] + mnL); p1[r] = p1[r] + mnL; }
  } else {
#pragma unroll
    for (int r = 0; r < 16; ++r) { p0[r] = __builtin_amdgcn_exp2f(fmaf(p0[r], C2, mnL)); p1[r] = fmaf(p1[r], C2, mnL); }
  }
  return false;
}
__device__ __forceinline__ void finishSM3(f32x16& p0, f32x16& p1, float alpha, float& l_reg, bf16x8& pa0, bf16x8& pa1, bf16x8& pa2, bf16x8& pa3) {
#pragma unroll
  for (int r = 0; r < 16; ++r) p1[r] = __builtin_amdgcn_exp2f(p1[r]);
  float ps = 0;
#pragma unroll
  for (int r = 0; r < 16; ++r) ps += p0[r];
#pragma unroll
  for (int r = 0; r < 16; ++r) ps += p1[r];
  { auto rr = __builtin_amdgcn_permlane32_swap(__float_as_uint(ps), __float_as_uint(ps), false, false);
    ps = __uint_as_float(rr[0]) + __uint_as_float(rr[1]); }
  l_reg = l_reg * alpha + ps;
#define PK4(P, B_, OUT) do { unsigned a0 = cvtpk(P[B_+0], P[B_+1]), a1 = cvtpk(P[B_+2], P[B_+3]);                          \
    unsigned b0 = cvtpk(P[B_+4], P[B_+5]), b1 = cvtpk(P[B_+6], P[B_+7]);                                             \
    auto r0 = __builtin_amdgcn_permlane32_swap(a0, b0, false, false); auto r1 = __builtin_amdgcn_permlane32_swap(a1, b1, false, false); \
    u32x4 w = {r0[0], r1[0], r0[1], r1[1]}; OUT = *reinterpret_cast<bf16x8*>(&w); } while (0)
  PK4(p0, 0, pa0); PK4(p0, 8, pa1); PK4(p1, 0, pa2); PK4(p1, 8, pa3);
#undef PK4
}
template <int KB>
__device__ __forceinline__ void qkt(f32x16& p0, f32x16& p1, const char* K_lds, int r32, int hi, const bf16x8* qr) {
  p0 = f32x16{}; p1 = f32x16{};
  const char* kb[4];
#pragma unroll
  for (int dd = 0; dd < 4; ++dd) kb[dd] = K_lds + KB * SHM_K + KSWZ(r32, (dd * 16 + hi * 8) * 2);
#pragma unroll
  for (int d0 = 0; d0 < 8; ++d0) { const char* a = kb[d0 & 3] + (d0 >> 2) * 128;
    bf16x8 b0 = *reinterpret_cast<const bf16x8*>(a);
    bf16x8 b1 = *reinterpret_cast<const bf16x8*>(a + 32 * 256);
    p0 = __builtin_amdgcn_mfma_f32_32x32x16_bf16(b0, qr[d0], p0, 0, 0, 0);
    p1 = __builtin_amdgcn_mfma_f32_32x32x16_bf16(b1, qr[d0], p1, 0, 0, 0); }
}
template <int VB>
__device__ __forceinline__ void pv_tile(f32x16* o, int vb0, bf16x8 pa0, bf16x8 pa1, bf16x8 pa2, bf16x8 pa3) {
#define TRRD(dst, off) asm volatile("ds_read_b64_tr_b16 %0, %1 offset:%2" : "=&v"(dst) : "v"(vb0), "i"(off) : "memory")
#define PV_D0(d0) do { s16x4 l0, l1, l2, l3, h0, h1, h2, h3; constexpr int b_ = VB * SHM_V + v_rd_off(d0, 0, 0); \
    TRRD(l0, b_); TRRD(h0, b_ + 2048); TRRD(l1, b_ + 4096); TRRD(h1, b_ + 6144); TRRD(l2, b_ + 8192); TRRD(h2, b_ + 10240); TRRD(l3, b_ + 12288); TRRD(h3, b_ + 14336); \
    asm volatile("s_waitcnt lgkmcnt(0)" ::: "memory"); SBAR();   \
    o[d0] = __builtin_amdgcn_mfma_f32_32x32x16_bf16(pa0, (bf16x8){l0[0], l0[1], l0[2], l0[3], h0[0], h0[1], h0[2], h0[3]}, o[d0], 0, 0, 0);   \
    o[d0] = __builtin_amdgcn_mfma_f32_32x32x16_bf16(pa1, (bf16x8){l1[0], l1[1], l1[2], l1[3], h1[0], h1[1], h1[2], h1[3]}, o[d0], 0, 0, 0);   \
    o[d0] = __builtin_amdgcn_mfma_f32_32x32x16_bf16(pa2, (bf16x8){l2[0], l2[1], l2[2], l2[3], h2[0], h2[1], h2[2], h2[3]}, o[d0], 0, 0, 0);   \
    o[d0] = __builtin_amdgcn_mfma_f32_32x32x16_bf16(pa3, (bf16x8){l3[0], l3[1], l3[2], l3[3], h3[0], h3[1], h3[2], h3[3]}, o[d0], 0, 0, 0); } while (0)
  PV_D0(0); PV_D0(1); PV_D0(2); PV_D0(3);
#undef PV_D0
#undef TRRD
}

template <int MODE>
__device__ __forceinline__ void attn_pass(char* lds, const bf16_t* Kp, const bf16_t* Vp, const float* cump, float cref, int j_lo, int NT,
                                          const bf16x8* qr, int posq, unsigned long long sel, f32x16* o, float& m_reg, float& l_reg, float qbound = 0.f) {
  LAUNDER_IDS
  const int tid = tix, wid = __builtin_amdgcn_readfirstlane(tid >> 6), lane = tid & 63, r32 = lane & 31, hi = lane >> 5;
  char* V_lds = lds; char* K_lds = lds + 2 * SHM_V;
  float* wsc = (float*)(lds + AT_SCR) + wid * 64; float* al_l = wsc + 32;
  float* cb = (float*)(lds + AT_CB);
  volatile int* xflag = (volatile int*)(lds + AT_Q + 16);
  const int sr = tid >> 4, sc = (tid & 15) * 8, vst0 = v_st(sr, sc), vst1 = v_st(32 + sr, sc), kws = KSWZ(sr, sc * 2);
  const int vb0 = (int)(uintptr_t)V_lds + v_rd_base(lane);
  bf16x8 st_v0, st_v1, st_k0, st_k1; float st_c = 0.f, st_b = 0.f;
  const int wminpos = __builtin_amdgcn_readfirstlane(posq);
  m_reg = -1e30f; l_reg = 0.f;
#pragma unroll
  for (int d = 0; d < 4; ++d) o[d] = f32x16{};
#define TJ(t) (MODE == 0 ? (j_lo + NT - 1 - (t)) : (j_lo + (t)))
#define SLOAD(t) do { const size_t k0_ = (size_t)TJ(t) * 64; \
    st_v0 = *(const bf16x8*)(Vp + (k0_ + sr) * 128 + sc); st_v1 = *(const bf16x8*)(Vp + (k0_ + 32 + sr) * 128 + sc); \
    st_k0 = *(const bf16x8*)(Kp + (k0_ + sr) * 128 + sc); st_k1 = *(const bf16x8*)(Kp + (k0_ + 32 + sr) * 128 + sc); \
    if (MODE == 0) { if (tid < 64) st_c = (cref - cump[k0_ + tid]) * LOG2E; st_b = cump[k0_ + 63]; } } while (0)
#define SWRITE(bf) do { *(bf16x8*)(V_lds + (bf) * SHM_V + vst0) = st_v0; *(bf16x8*)(V_lds + (bf) * SHM_V + vst1) = st_v1; \
    *(bf16x8*)(K_lds + (bf) * SHM_K + kws) = st_k0; *(bf16x8*)(K_lds + (bf) * SHM_K + kws + 32 * 256) = st_k1; \
    if (MODE == 0 && tid < 64) cb[(bf) * 64 + tid] = st_c; } while (0)
#define STEP(t, BUF) do { \
    if ((t) + 1 < NT) SLOAD((t) + 1); \
    f32x16 p0, p1; \
    qkt<BUF>(p0, p1, K_lds, r32, hi, qr); \
    if (MODE == 0) { _Pragma("unroll") for (int i = 0; i < 4; ++i) { const f32x4 c0 = *(const f32x4*)(cb + (BUF) * 64 + 8 * i + 4 * hi); const f32x4 c1 = *(const f32x4*)(cb + (BUF) * 64 + 32 + 8 * i + 4 * hi); \
        _Pragma("unroll") for (int j = 0; j < 4; ++j) { p0[4 * i + j] = fmaf(p0[4 * i + j], C2, c0[j]); p1[4 * i + j] = fmaf(p1[4 * i + j], C2, c1[j]); } } } \
    { const int kb_ = TJ(t) * 64; \
      const bool need = (MODE == 1) || (kb_ + 63 > wminpos) || (MODE == 2 && kb_ + 511 < wminpos + 7); \
      if (need) mask_tile(p0, p1, posq - kb_ - 4 * hi, MODE == 2 ? 512u : 0x7fffffffu); } \
    const bool rsel = (MODE != 3) || (((sel >> TJ(t)) & 1ull) != 0ull); \
    float alpha; const bool dead = partialSM3<MODE>(p0, p1, m_reg, alpha, rsel); \
    if (!dead) { \
    if (__any(alpha < 1.f)) { if (hi == 0) al_l[r32] = alpha; asm volatile("s_waitcnt lgkmcnt(0)" ::: "memory"); \
      _Pragma("unroll") for (int d_ = 0; d_ < 4; ++d_) _Pragma("unroll") for (int r = 0; r < 16; ++r) o[d_][r] *= al_l[crow(r, hi)]; } \
    bf16x8 pa0, pa1, pa2, pa3; \
    finishSM3(p0, p1, alpha, l_reg, pa0, pa1, pa2, pa3); SBAR(); \
    pv_tile<BUF>(o, vb0, pa0, pa1, pa2, pa3); \
    } \
    if ((t) + 1 < NT) { asm volatile("s_waitcnt vmcnt(0)" ::: "memory"); SWRITE((BUF) ^ 1); } \
    if (MODE == 0 && (t) + 1 < NT) { const float bmax_ = (cref - st_b) * LOG2E;     \
      const bool done_ = __all(qbound + bmax_ - m_reg < -160.f); if (lane == 0) xflag[((t) & 1) * 8 + wid] = done_ ? 1 : 0; } \
    __syncthreads(); \
    if (MODE == 0 && (t) + 1 < NT) { int all_ = 1; _Pragma("unroll") for (int w_ = 0; w_ < 8; ++w_) all_ &= xflag[((t) & 1) * 8 + w_]; stop = all_ != 0; } } while (0)
  SLOAD(0); asm volatile("s_waitcnt vmcnt(0)" ::: "memory"); SWRITE(0); __syncthreads();
  bool stop = false;
  for (int t = 0; t < NT; t += 2) {
    STEP(t, 0);
    if (stop) break;
    if (t + 1 < NT) { STEP(t + 1, 1); if (stop) break; }
  }
#undef SLOAD
#undef SWRITE
#undef STEP
#undef TJ
}

__device__ __forceinline__ void cmp_importance(char* lds, const bf16_t* Kp, int NT, const bf16x8* qr, int nmax, float m_reg, float l_reg) {
  LAUNDER_IDS
  const int tid = tix, wid = __builtin_amdgcn_readfirstlane(tid >> 6), lane = tid & 63, r32 = lane & 31, hi = lane >> 5;
  char* K_lds = lds + 2 * SHM_V;
  float* U = (float*)(lds + AT_IMPU) + wid * 512; float* Wv = (float*)(lds + AT_IMPW) + wid * 512;
  const int sr = tid >> 4, sc = (tid & 15) * 8, kws = KSWZ(sr, sc * 2);
#pragma unroll
  for (int i = 0; i < 8; ++i) { U[i * 64 + lane] = 0.f; Wv[i * 64 + lane] = 0.f; }
  const float rl = l_reg > 0.f ? 1.f / l_reg : 0.f;
  const int tl = r32 >> 2;
  for (int t = 0; t < NT; ++t) {
    { const size_t k0 = (size_t)t * 64; const bf16x8 k0v = *(const bf16x8*)(Kp + (k0 + sr) * 128 + sc); const bf16x8 k1v = *(const bf16x8*)(Kp + (k0 + 32 + sr) * 128 + sc);
      *(bf16x8*)(K_lds + kws) = k0v; *(bf16x8*)(K_lds + kws + 32 * 256) = k1v; }
    __syncthreads();
    f32x16 p0, p1;
    qkt<0>(p0, p1, K_lds, r32, hi, qr);
#pragma unroll
    for (int r = 0; r < 16; ++r) { p0[r] *= C2; p1[r] *= C2; }
    mask_tile(p0, p1, nmax - t * 64 - 4 * hi, 0x7fffffffu);
#pragma unroll
    for (int r = 0; r < 16; ++r) { p0[r] = __builtin_amdgcn_exp2f(p0[r] - m_reg) * rl; p1[r] = __builtin_amdgcn_exp2f(p1[r] - m_reg) * rl; }
#pragma unroll
    for (int i = 0; i < 4; ++i) {
      float u0 = p0[4 * i] + p0[4 * i + 1] + p0[4 * i + 2] + 0.5f * p0[4 * i + 3], w0 = 0.5f * p0[4 * i + 3];
      float u1 = p1[4 * i] + p1[4 * i + 1] + p1[4 * i + 2] + 0.5f * p1[4 * i + 3], w1 = 0.5f * p1[4 * i + 3];
      u0 += __shfl_xor(u0, 1); u0 += __shfl_xor(u0, 2); w0 += __shfl_xor(w0, 1); w0 += __shfl_xor(w0, 2);
      u1 += __shfl_xor(u1, 1); u1 += __shfl_xor(u1, 2); w1 += __shfl_xor(w1, 1); w1 += __shfl_xor(w1, 2);
      if ((r32 & 3) == 0) { const int b0 = 16 * t + 2 * i + hi, b1 = b0 + 8;
        U[tl * 64 + b0] = u0; U[tl * 64 + b1] = u1; Wv[tl * 64 + b0 + 1] = w0; if (b1 + 1 < 64) Wv[tl * 64 + b1 + 1] = w1; }
    }
    __syncthreads();
  }
}

__device__ __forceinline__ unsigned long long topk_select(char* lds, int c) {
  LAUNDER_IDS
  const int tid = tix, wid = __builtin_amdgcn_readfirstlane(tid >> 6), lane = tid & 63, r32 = lane & 31;
  const float* U = (const float*)(lds + AT_IMPU) + wid * 512; const float* Wv = (const float*)(lds + AT_IMPW) + wid * 512;
  unsigned long long mysel = 0ull;
  for (int tl = 0; tl < 8; ++tl) {
    float v = U[tl * 64 + lane] + Wv[tl * 64 + lane];
    if (lane == 0 || lane == c || lane == c - 1) v = 1e6f; else if (lane > c) v = -1.f;
    int rank = 0;
#pragma unroll
    for (int i = 0; i < 64; ++i) { const float vi = __uint_as_float(__builtin_amdgcn_readlane(__float_as_uint(v), i)); rank += (vi > v || (vi == v && i < lane)) ? 1 : 0; }
    const unsigned long long m = __ballot(rank < 16 && v >= 0.f);
    if ((r32 >> 2) == tl) mysel = m;
  }
  return mysel;
}

template <int KIND>
__device__ __forceinline__ void attn_store(char* lds, const f32x16* o, float l_reg, const Params& p, int b, int hg, int P0, int br) {
  LAUNDER_IDS
  const int tid = tix, wid = __builtin_amdgcn_readfirstlane(tid >> 6), lane = tid & 63, r32 = lane & 31, hi = lane >> 5;
  float* li_l = (float*)(lds + AT_SCR) + wid * 64;
  if (hi == 0) li_l[r32] = l_reg; asm volatile("s_waitcnt lgkmcnt(0)" ::: "memory");
  bf16_t* __restrict__ oatt = (bf16_t*)(p.ws + WS_OATT); float* __restrict__ oacc = (float*)(p.ws + WS_ABUF); const float* __restrict__ small = (const float*)(p.ws + WS_SMALL);
  float sc[16];
#pragma unroll
  for (int r = 0; r < 16; ++r) { const int row = crow(r, hi); const float lv = li_l[row]; sc[r] = lv > 0.f ? __builtin_amdgcn_rcpf(lv) : 0.f; }
  if (KIND == 0) {
#pragma unroll
    for (int r = 0; r < 16; ++r) {
      const int row = crow(r, hi); const size_t tok = (size_t)b * 4096 + P0 + wid * 32 + row;
#pragma unroll
      for (int d0 = 0; d0 < 4; ++d0) { const float v = o[d0][r] * sc[r]; const float vn = __shfl_xor(v, 1);
        if ((r32 & 1) == 0) *(unsigned*)(oatt + tok * 2048 + hg * 128 + d0 * 32 + r32) = cvtpk(v, vn); }
    }
  } else {
    float gt[16];
#pragma unroll
    for (int r = 0; r < 16; ++r) { const int row = crow(r, hi); const int head = hg * 4 + (row & 3); const size_t tok = (size_t)b * 4096 + P0 + wid * 8 + (row >> 2);
      gt[r] = small[tok * 32 + 8 + head * 3 + br]; }
    float prev[16][4];
    if (KIND >= 2) {
#pragma unroll
      for (int r = 0; r < 16; ++r) { const int row = crow(r, hi); const int head = hg * 4 + (row & 3); const size_t tok = (size_t)b * 4096 + P0 + wid * 8 + (row >> 2);
        const float* ap = oacc + tok * 1024 + head * 128 + r32;
#pragma unroll
        for (int d0 = 0; d0 < 4; ++d0) prev[r][d0] = ap[d0 * 32]; }
    }
#pragma unroll
    for (int r = 0; r < 16; ++r) { const int row = crow(r, hi); const int head = hg * 4 + (row & 3); const size_t tok = (size_t)b * 4096 + P0 + wid * 8 + (row >> 2);
      const float scg = sc[r] * sigmoidf_(gt[r]);
      float* ap = oacc + tok * 1024 + head * 128 + r32;
#pragma unroll
      for (int d0 = 0; d0 < 4; ++d0) { float v = o[d0][r] * scg;
        if (KIND >= 2) v += prev[r][d0];
        if (KIND < 3) ap[d0 * 32] = v;
        else { const float vn = __shfl_xor(v, 1); if ((r32 & 1) == 0) *(unsigned*)(oatt + tok * 2048 + 1024 + head * 128 + d0 * 32 + r32) = cvtpk(v, vn); } } }
  }
}

__device__ __forceinline__ void attention_phase(const Params& p, int l, char* lds) {
  LAUNDER_IDS
  const int tid = tix, wid = __builtin_amdgcn_readfirstlane(tid >> 6), lane = tid & 63, r32 = lane & 31, hi = lane >> 5;
  unsigned* ctr = (unsigned*)(p.ws + WS_CTL) + l; const int* order = (const int*)(p.ws + WS_ORDER);
  volatile int* qslot = (volatile int*)(lds + AT_Q);
  const unsigned char* proj = p.ws + WS_PROJ;
  for (;;) {
    if (tid == 0) *qslot = (int)atomicAdd(ctr, 1u);
    __syncthreads();
    const int qi = *qslot;
    __syncthreads();
    if (qi >= 1024 + T_FFN) break;
    if (qi >= 1024) { convert_ffn_tile(p, l, qi - 1024, (float*)lds); continue; }
    const int id = order[qi];
    bf16x8 qr[8]; f32x16 o[4]; float m_reg, l_reg;
    if (id < 512) {
      const int b = id >> 7, h = (id >> 4) & 7, xq = id & 15, P0 = xq * 256; const int bh = b * 8 + h;
      const bf16_t* Q = (const bf16_t*)(proj + PJ_FQ) + (size_t)bh * 4096 * 128; const bf16_t* K = (const bf16_t*)(proj + PJ_FK) + (size_t)bh * 4096 * 128; const bf16_t* V = (const bf16_t*)(proj + PJ_FV) + (size_t)bh * 4096 * 128;
      const float* cum = (const float*)(p.ws + WS_CUM) + bh * 4096;
      const int pos = P0 + wid * 32 + r32;
#pragma unroll
      for (int d0 = 0; d0 < 8; ++d0) qr[d0] = *(const bf16x8*)(Q + (size_t)pos * 128 + d0 * 16 + hi * 8);
      float qb;
      { float qs = 0.f;
#pragma unroll
        for (int d0 = 0; d0 < 8; ++d0) { const u32x4 w = *reinterpret_cast<const u32x4*>(&qr[d0]);
          qs += bflo(w.x) * bflo(w.x) + bfhi(w.x) * bfhi(w.x) + bflo(w.y) * bflo(w.y) + bfhi(w.y) * bfhi(w.y) + bflo(w.z) * bflo(w.z) + bfhi(w.z) * bfhi(w.z) + bflo(w.w) * bflo(w.w) + bfhi(w.w) * bfhi(w.w); }
        auto rr = __builtin_amdgcn_permlane32_swap(__float_as_uint(qs), __float_as_uint(qs), false, false);
        qs = __uint_as_float(rr[0]) + __uint_as_float(rr[1]);
        const float k2 = __uint_as_float(((const unsigned*)(p.ws + WS_CTL + 256))[l * 32 + bh]);
        qb = sqrtf(qs * k2) * (C2 * 1.01f) + 1.f; }
      attn_pass<0>(lds, K, V, cum, cum[P0], 0, 4 * (xq + 1), qr, pos, 0ull, o, m_reg, l_reg, qb);
      attn_store<0>(lds, o, l_reg, p, b, h, P0, 0);
    } else {
      const int n = id - 512, b = n >> 7, g = (n >> 6) & 1, c = n & 63, P0 = c * 64; const int bg = b * 2 + g;
      const int pos = P0 + wid * 8 + (r32 >> 2); const int head = g * 4 + (r32 & 3);
      const bf16_t* Q = (const bf16_t*)(proj + PJ_NQ) + ((size_t)(b * 8 + head) * 4096 + pos) * 128;
#pragma unroll
      for (int d0 = 0; d0 < 8; ++d0) qr[d0] = *(const bf16x8*)(Q + d0 * 16 + hi * 8);
      const bf16_t* kvb = (const bf16_t*)(proj + PJ_KV);
      const size_t kvo = (size_t)bg * 4096 * 128, kvs = SZ_KV / 2;
      const bf16_t* Kc = (const bf16_t*)(p.ws + WS_KC) + (size_t)bg * 256 * 128; const bf16_t* Vc = (const bf16_t*)(p.ws + WS_VC) + (size_t)bg * 256 * 128;
      int nmax = (pos >= 31) ? ((pos - 31) >> 4) : -1; if (nmax > 254) nmax = 254;
      const int NTc = (4 * c + 2) / 64 + 1;
      attn_pass<1>(lds, Kc, Vc, nullptr, 0.f, 0, NTc, qr, nmax, 0ull, o, m_reg, l_reg);
      attn_store<1>(lds, o, l_reg, p, b, g, P0, 0);
      cmp_importance(lds, Kc, NTc, qr, nmax, m_reg, l_reg);
      const unsigned long long sel = topk_select(lds, c);
      { const int jl = c >= 8 ? c - 8 : 0;
        attn_pass<2>(lds, kvb + 4 * kvs + kvo, kvb + 5 * kvs + kvo, nullptr, 0.f, jl, c - jl + 1, qr, pos, 0ull, o, m_reg, l_reg);
        attn_store<2>(lds, o, l_reg, p, b, g, P0, 2); }
      attn_pass<3>(lds, kvb + 2 * kvs + kvo, kvb + 3 * kvs + kvo, nullptr, 0.f, 0, c + 1, qr, pos, sel, o, m_reg, l_reg);
      attn_store<3>(lds, o, l_reg, p, b, g, P0, 1);
    }
  }
}


#define XB_TMO      128
#define XB_XCNT(j)  (256  + 64 * (j))
#define XB_XSUB(j)  (1280 + 64 * (j))
#define XB_XGEN(j)  (2304 + 64 * (j))
#define XB_TOP      3328
#define XB_TOPGEN   3392
#define XCD_BAR_WORDS 3456
#define XB_SPIN_CAP (1u << 18)
__device__ __forceinline__ unsigned xb_ld(unsigned* p)              { return __hip_atomic_load(p, __ATOMIC_RELAXED, __HIP_MEMORY_SCOPE_AGENT); }
__device__ __forceinline__ unsigned xb_add(unsigned* p, unsigned v) { return __hip_atomic_fetch_add(p, v, __ATOMIC_RELAXED, __HIP_MEMORY_SCOPE_AGENT); }
__device__ __forceinline__ unsigned xb_xcc_id() { return (unsigned)__builtin_amdgcn_s_getreg((3 << 11) | 20) & 0xFu; }
#define XB_SPIN(cond, bar) do { unsigned _sp = 0; while (cond) { __builtin_amdgcn_s_sleep(1); \
    if ((++_sp & 255u) == 0u) { if (xb_ld(&(bar)[XB_TMO])) break; if (_sp > XB_SPIN_CAP) { atomicAdd(&(bar)[XB_TMO], 1u); break; } } } } while (0)
struct XcdBarrier { unsigned* bar; unsigned x; volatile LAS unsigned* st; };
__device__ __forceinline__ XcdBarrier xcd_barrier_post(unsigned* bar, volatile LAS unsigned* st) {
    XcdBarrier b; b.bar = bar; b.x = xb_xcc_id(); b.st = st;
    if (threadIdx.x == 0) (void)xb_add(&bar[XB_XCNT(b.x)], 1u);
    return b;
}
__device__ __forceinline__ void xcd_barrier_complete(unsigned* bar, unsigned x, unsigned& nloc, unsigned& nx) {
    const unsigned G = gridDim.x * gridDim.y * gridDim.z;
    unsigned sum, cnt, mine, sp = 0u;
    for (;;) {
        sum = 0u; cnt = 0u; mine = 0u;
#pragma unroll
        for (unsigned j = 0; j < 16; ++j) { const unsigned c = xb_ld(&bar[XB_XCNT(j)]); sum += c; cnt += (c > 0u) ? 1u : 0u; mine = (j == x) ? c : mine; }
        if (sum == G) break;
        __builtin_amdgcn_s_sleep(1);
        if ((++sp & 255u) == 0u) { if (xb_ld(&bar[XB_TMO])) break; if (sp > XB_SPIN_CAP) { atomicAdd(&bar[XB_TMO], 1u); break; } }
    }
    nloc = mine > 0u ? mine : 1u; nx = cnt > 0u ? cnt : 1u;
}
__device__ __attribute__((noinline)) void xcd_barrier_impl(unsigned* bar_, unsigned bx_, volatile LAS unsigned* st_) {
    XcdBarrier b; b.bar = bar_; b.x = bx_; b.st = st_;
    asm volatile("s_waitcnt vmcnt(0)" ::: "memory");
    __syncthreads();
    if (threadIdx.x == 0) {
        unsigned* bar = b.bar;
        __builtin_amdgcn_s_waitcnt(0);
        unsigned nloc = b.st[0], nx = b.st[1];
        if (nloc == 0u) { xcd_barrier_complete(bar, b.x, nloc, nx); b.st[0] = nloc; b.st[1] = nx; }
        const unsigned old = xb_add(&bar[XB_XSUB(b.x)], 1u);
        const unsigned gen = old / nloc;
        if (old + 1u == (gen + 1u) * nloc) {
            __builtin_amdgcn_fence(__ATOMIC_RELEASE, "agent");
            asm volatile("s_waitcnt vmcnt(0)" ::: "memory");
            const unsigned og = xb_add(&bar[XB_TOP], 1u);
            const unsigned tg = og / nx;
            if (og + 1u == (tg + 1u) * nx) xb_add(&bar[XB_TOPGEN], 1u);
            else XB_SPIN(xb_ld(&bar[XB_TOPGEN]) == tg, bar);
            __builtin_amdgcn_fence(__ATOMIC_ACQUIRE, "agent");
            xb_add(&bar[XB_XGEN(b.x)], 1u);
            asm volatile("s_waitcnt vmcnt(0)" ::: "memory");
        } else {
            XB_SPIN(xb_ld(&bar[XB_XGEN(b.x)]) == gen, bar);
            __builtin_amdgcn_fence(__ATOMIC_ACQUIRE, "agent");
            asm volatile("s_waitcnt vmcnt(0)" ::: "memory");
        }
    }
    __syncthreads();
}

__global__ void __launch_bounds__(NTHR, 2) mega(Params p_arg) {
  typedef const __attribute__((address_space(4))) Params* KP;
  const KP kp0 = (KP)__builtin_amdgcn_kernarg_segment_ptr();
  (void)p_arg;
  extern __shared__ __attribute__((aligned(16))) unsigned char lds[];
  cg::grid_group grid = cg::this_grid();
  LAS unsigned char* ldsl = (LAS unsigned char*)lds;
  constexpr int ST_OFF = 136 * 1024 - 64;
  if (threadIdx.x < 4) ((LAS unsigned*)(ldsl + ST_OFF))[threadIdx.x] = 0u;
  __syncthreads();
    { KP kp = kp0; asm volatile("" : "+s"(kp)); const Params p = *(const Params*)kp; unsigned char* ws = p.ws; unsigned char* wt = ws + WS_WT; unsigned char* proj = ws + WS_PROJ; bf16_t* abuf = (bf16_t*)(ws + WS_ABUF); bf16_t* oatt = (bf16_t*)(ws + WS_OATT); bf16_t* ybuf = (bf16_t*)(ws + WS_Y); float* ssq = (float*)(ws + WS_SSQ); float* small = (float*)(ws + WS_SMALL); (void)wt; (void)proj; (void)abuf; (void)oatt; (void)ybuf; (void)ssq; (void)small;
  if (blockIdx.x == 0) sort_items(p, (int*)lds);
  rope_tables(p);
  convert_mixer(p, 0, (float*)lds);
  row_phase(0, p.x, nullptr, nullptr, nullptr, nullptr, p.n_mix_pre, abuf);
    }
  grid.sync();
  const XcdBarrier xbar = xcd_barrier_post((unsigned*)(((const Params*)kp0)->ws + WS_BAR), (volatile LAS unsigned*)(ldsl + ST_OFF));

  for (int l = 0; l < 2; ++l) {
    { KP kp = kp0; asm volatile("" : "+s"(kp)); const Params p = *(const Params*)kp; unsigned char* ws = p.ws; unsigned char* wt = ws + WS_WT; unsigned char* proj = ws + WS_PROJ; bf16_t* abuf = (bf16_t*)(ws + WS_ABUF); bf16_t* oatt = (bf16_t*)(ws + WS_OATT); bf16_t* ybuf = (bf16_t*)(ws + WS_Y); float* ssq = (float*)(ws + WS_SSQ); float* small = (float*)(ws + WS_SMALL); (void)wt; (void)proj; (void)abuf; (void)oatt; (void)ybuf; (void)ssq; (void)small;
    { StaticOrder S; S.init(abuf, (const bf16_t*)(wt + WT_IN), DM, DM, NTOK, INP);
      EpiIn E{proj, small, (const float*)(ws + WS_ROPEQ)};
      gemm_phase<EpiIn, StaticOrder>(ldsl, DM, DM, DM, S, E); }
    }
    xcd_barrier_impl(xbar.bar, xbar.x, xbar.st);
    { KP kp = kp0; asm volatile("" : "+s"(kp)); const Params p = *(const Params*)kp; unsigned char* ws = p.ws; unsigned char* wt = ws + WS_WT; unsigned char* proj = ws + WS_PROJ; bf16_t* abuf = (bf16_t*)(ws + WS_ABUF); bf16_t* oatt = (bf16_t*)(ws + WS_OATT); bf16_t* ybuf = (bf16_t*)(ws + WS_Y); float* ssq = (float*)(ws + WS_SSQ); float* small = (float*)(ws + WS_SMALL); (void)wt; (void)proj; (void)abuf; (void)oatt; (void)ybuf; (void)ssq; (void)small;
    cumsum_phase(p, l, (float*)lds);
    kmax_phase(p, l);
    { CmpOrder S{(const bf16_t*)(proj + PJ_KV), (const bf16_t*)(proj + PJ_KV + SZ_KV), (const bf16_t*)(wt + WT_C1K), (const bf16_t*)(wt + WT_C1V), (int)gridDim.x, launder_s((int)blockIdx.x)};
      EpiPartial E{(bf16_t*)(ws + WS_Y)};
      gemm_phase<EpiPartial, CmpOrder>(ldsl, 2048, 4096, 256, S, E); }
    }
    xcd_barrier_impl(xbar.bar, xbar.x, xbar.st);
    { KP kp = kp0; asm volatile("" : "+s"(kp)); const Params p = *(const Params*)kp; unsigned char* ws = p.ws; unsigned char* wt = ws + WS_WT; unsigned char* proj = ws + WS_PROJ; bf16_t* abuf = (bf16_t*)(ws + WS_ABUF); bf16_t* oatt = (bf16_t*)(ws + WS_OATT); bf16_t* ybuf = (bf16_t*)(ws + WS_Y); float* ssq = (float*)(ws + WS_SSQ); float* small = (float*)(ws + WS_SMALL); (void)wt; (void)proj; (void)abuf; (void)oatt; (void)ybuf; (void)ssq; (void)small;
    cmp_finish(p, l, (float*)lds);
    }
    xcd_barrier_impl(xbar.bar, xbar.x, xbar.st);
    { KP kp = kp0; asm volatile("" : "+s"(kp)); const Params p = *(const Params*)kp; unsigned char* ws = p.ws; unsigned char* wt = ws + WS_WT; unsigned char* proj = ws + WS_PROJ; bf16_t* abuf = (bf16_t*)(ws + WS_ABUF); bf16_t* oatt = (bf16_t*)(ws + WS_OATT); bf16_t* ybuf = (bf16_t*)(ws + WS_Y); float* ssq = (float*)(ws + WS_SSQ); float* small = (float*)(ws + WS_SMALL); (void)wt; (void)proj; (void)abuf; (void)oatt; (void)ybuf; (void)ssq; (void)small;
    attention_phase(p, l, (char*)lds);
    }
    xcd_barrier_impl(xbar.bar, xbar.x, xbar.st);
    { KP kp = kp0; asm volatile("" : "+s"(kp)); const Params p = *(const Params*)kp; unsigned char* ws = p.ws; unsigned char* wt = ws + WS_WT; unsigned char* proj = ws + WS_PROJ; bf16_t* abuf = (bf16_t*)(ws + WS_ABUF); bf16_t* oatt = (bf16_t*)(ws + WS_OATT); bf16_t* ybuf = (bf16_t*)(ws + WS_Y); float* ssq = (float*)(ws + WS_SSQ); float* small = (float*)(ws + WS_SMALL); (void)wt; (void)proj; (void)abuf; (void)oatt; (void)ybuf; (void)ssq; (void)small;
    { CatOrder S; S.base.init(oatt, (const bf16_t*)(ws + WS_WT2 + W2_UPF), DM, 1024, NTOK, DM); S.B1 = (const bf16_t*)(ws + WS_WT2 + W2_UPN);
      EpiUpCat E{(const bf16_t*)(proj + PJ_GF), (const bf16_t*)(proj + PJ_GN), abuf};
      gemm_phase<EpiUpCat, CatOrder>(ldsl, DM, 1024, 1024, S, E); }
    }
    xcd_barrier_impl(xbar.bar, xbar.x, xbar.st);
    { KP kp = kp0; asm volatile("" : "+s"(kp)); const Params p = *(const Params*)kp; unsigned char* ws = p.ws; unsigned char* wt = ws + WS_WT; unsigned char* proj = ws + WS_PROJ; bf16_t* abuf = (bf16_t*)(ws + WS_ABUF); bf16_t* oatt = (bf16_t*)(ws + WS_OATT); bf16_t* ybuf = (bf16_t*)(ws + WS_Y); float* ssq = (float*)(ws + WS_SSQ); float* small = (float*)(ws + WS_SMALL); (void)wt; (void)proj; (void)abuf; (void)oatt; (void)ybuf; (void)ssq; (void)small;
    { StaticOrder S; S.init(abuf, (const bf16_t*)(ws + WS_WT2 + W2_OUT), DM, DM, NTOK, DM);
      EpiY E{ybuf, ssq};
      gemm_phase<EpiY, StaticOrder>(ldsl, DM, DM, DM, S, E); }
    }
    xcd_barrier_impl(xbar.bar, xbar.x, xbar.st);
    { KP kp = kp0; asm volatile("" : "+s"(kp)); const Params p = *(const Params*)kp; unsigned char* ws = p.ws; unsigned char* wt = ws + WS_WT; unsigned char* proj = ws + WS_PROJ; bf16_t* abuf = (bf16_t*)(ws + WS_ABUF); bf16_t* oatt = (bf16_t*)(ws + WS_OATT); bf16_t* ybuf = (bf16_t*)(ws + WS_Y); float* ssq = (float*)(ws + WS_SSQ); float* small = (float*)(ws + WS_SMALL); (void)wt; (void)proj; (void)abuf; (void)oatt; (void)ybuf; (void)ssq; (void)small;
    const float* xin = (l == 0) ? p.x : p.out;
    row_phase(1, xin, p.out, ybuf, ssq, p.n_mix_post + l * DM, p.n_ffn_pre + l * DM, abuf);
    }
    xcd_barrier_impl(xbar.bar, xbar.x, xbar.st);
    { KP kp = kp0; asm volatile("" : "+s"(kp)); const Params p = *(const Params*)kp; unsigned char* ws = p.ws; unsigned char* wt = ws + WS_WT; unsigned char* proj = ws + WS_PROJ; bf16_t* abuf = (bf16_t*)(ws + WS_ABUF); bf16_t* oatt = (bf16_t*)(ws + WS_OATT); bf16_t* ybuf = (bf16_t*)(ws + WS_Y); float* ssq = (float*)(ws + WS_SSQ); float* small = (float*)(ws + WS_SMALL); (void)wt; (void)proj; (void)abuf; (void)oatt; (void)ybuf; (void)ssq; (void)small;
    { StaticOrder S; S.init(abuf, (const bf16_t*)(wt + WT_GU), DM, DM, NTOK, 2 * FFH);
      EpiSwiglu E{(bf16_t*)proj};
      gemm_phase<EpiSwiglu, StaticOrder>(ldsl, DM, DM, DM, S, E); }
    }
    xcd_barrier_impl(xbar.bar, xbar.x, xbar.st);
    { KP kp = kp0; asm volatile("" : "+s"(kp)); const Params p = *(const Params*)kp; unsigned char* ws = p.ws; unsigned char* wt = ws + WS_WT; unsigned char* proj = ws + WS_PROJ; bf16_t* abuf = (bf16_t*)(ws + WS_ABUF); bf16_t* oatt = (bf16_t*)(ws + WS_OATT); bf16_t* ybuf = (bf16_t*)(ws + WS_Y); float* ssq = (float*)(ws + WS_SSQ); float* small = (float*)(ws + WS_SMALL); (void)wt; (void)proj; (void)abuf; (void)oatt; (void)ybuf; (void)ssq; (void)small;
    { StaticOrder S; S.init((const bf16_t*)proj, (const bf16_t*)(wt + WT_DOWN), FFH, FFH, NTOK, DM);
      EpiY E{ybuf, ssq};
      gemm_phase<EpiY, StaticOrder>(ldsl, FFH, FFH, FFH, S, E); }
    }
    xcd_barrier_impl(xbar.bar, xbar.x, xbar.st);
    { KP kp = kp0; asm volatile("" : "+s"(kp)); const Params p = *(const Params*)kp; unsigned char* ws = p.ws; unsigned char* wt = ws + WS_WT; unsigned char* proj = ws + WS_PROJ; bf16_t* abuf = (bf16_t*)(ws + WS_ABUF); bf16_t* oatt = (bf16_t*)(ws + WS_OATT); bf16_t* ybuf = (bf16_t*)(ws + WS_Y); float* ssq = (float*)(ws + WS_SSQ); float* small = (float*)(ws + WS_SMALL); (void)wt; (void)proj; (void)abuf; (void)oatt; (void)ybuf; (void)ssq; (void)small;
    if (l == 0) convert_mixer(p, 1, (float*)lds);
    row_phase(1, p.out, p.out, ybuf, ssq, p.n_ffn_post + l * DM, (l == 0) ? p.n_mix_pre + DM : nullptr, abuf);
    }
    if (l == 0) xcd_barrier_impl(xbar.bar, xbar.x, xbar.st);
  }
}

extern "C" void kernel_launch(void* const* d_in, const int* in_sizes, int n_in, void* d_out, int out_size, void* d_ws, size_t ws_size, hipStream_t stream) {
  constexpr int LDSB = 136 * 1024;
  static_assert(AT_END <= LDSB && STAGE_BYTES <= LDSB, "lds");
  static int grid_blocks = 0;
  if (!grid_blocks) {
    int dev = 0, cus = 0, per_cu = 0;
    (void)hipGetDevice(&dev);
    (void)hipDeviceGetAttribute(&cus, hipDeviceAttributeMultiprocessorCount, dev);
    (void)hipFuncSetAttribute((const void*)mega, hipFuncAttributeMaxDynamicSharedMemorySize, LDSB);
    (void)hipOccupancyMaxActiveBlocksPerMultiprocessor(&per_cu, (const void*)mega, NTHR, LDSB);
    if (per_cu < 1) per_cu = 1;
    grid_blocks = cus * 1;
    if (grid_blocks != 256) { fprintf(stderr, "this build deals rows for a 256-block grid; device reports %d CUs\n", cus); grid_blocks = 256; }
    if (ws_size < WS_END) fprintf(stderr, "workspace too small: %zu < %zu\n", ws_size, (size_t)WS_END);
    fprintf(stderr, "grid %d (cus %d per_cu %d) ws %zu need %zu\n", grid_blocks, cus, per_cu, ws_size, (size_t)WS_END);
  }
  Params p{};
  p.x = (const float*)d_in[0]; p.n_mix_pre = (const float*)d_in[1]; p.n_mix_post = (const float*)d_in[2]; p.n_ffn_pre = (const float*)d_in[3]; p.n_ffn_post = (const float*)d_in[4];
  p.w_in = (const float*)d_in[5]; p.f_bias = (const float*)d_in[6]; p.ck_pe = (const float*)d_in[7]; p.ck_w1 = (const float*)d_in[8]; p.ck_w2 = (const float*)d_in[9];
  p.cv_pe = (const float*)d_in[10]; p.cv_w1 = (const float*)d_in[11]; p.cv_w2 = (const float*)d_in[12]; p.w_up_fox = (const float*)d_in[13]; p.w_up_nsa = (const float*)d_in[14];
  p.w_out = (const float*)d_in[15]; p.w_gate = (const float*)d_in[16]; p.w_up = (const float*)d_in[17]; p.w_down = (const float*)d_in[18];
  p.out = (float*)d_out; p.ws = (unsigned char*)d_ws;
  void* args[] = {&p};
  hipError_t e = hipLaunchCooperativeKernel((const void*)mega, dim3(grid_blocks), dim3(NTHR), args, LDSB, stream);
  if (e != hipSuccess) fprintf(stderr, "cooperative launch failed: %s (grid %d)\n", hipGetErrorString(e), grid_blocks);
}
```

```cpp
#include <hip/hip_runtime.h>
#include <hip/hip_cooperative_groups.h>
#include <cstdio>
#include <cstdint>
namespace cg = cooperative_groups;

#define LAS __attribute__((address_space(3)))
typedef unsigned short bf16_t;
typedef short bf16x8 __attribute__((ext_vector_type(8)));
typedef short s16x4 __attribute__((ext_vector_type(4)));
typedef float f32x2 __attribute__((ext_vector_type(2)));
typedef float f32x4 __attribute__((ext_vector_type(4)));
typedef float f32x16 __attribute__((ext_vector_type(16)));
typedef unsigned u32x2 __attribute__((ext_vector_type(2)));
typedef unsigned u32x4 __attribute__((ext_vector_type(4)));

constexpr int NTOK = 16384, TT = 4096, DM = 2048, FFH = 5632, INW = 9760, INP = 9984;
constexpr float EPSN = 1e-6f;
constexpr float LOG2E = 1.4426950408889634f;
constexpr float SCALE = 0.08838834764831845f;
constexpr float C2 = LOG2E * SCALE;
constexpr int NTHR = 512;

constexpr size_t WS_CTL = 0;
constexpr size_t WS_ORDER = 4096;
constexpr size_t WS_ROPEQ = 8192;
constexpr size_t WS_ROPEC = WS_ROPEQ + 2 * 4096 * 16 * 4;
constexpr size_t WS_PEB = WS_ROPEC + 2 * 256 * 16 * 4;
constexpr size_t WS_CUM = WS_PEB + 2 * 32 * 256 * 4;
constexpr size_t WS_SMALL = WS_CUM + 32 * 4096 * 4;
constexpr size_t WS_SSQ = WS_SMALL + (size_t)NTOK * 32 * 4;
constexpr size_t WS_KC = WS_SSQ + (size_t)NTOK * 32 * 4;
constexpr size_t WS_VC = WS_KC + 8 * 256 * 128 * 2;
constexpr size_t WS_BAR = WS_VC + 8 * 256 * 128 * 2;
constexpr size_t WS_WT = WS_BAR + 16384;
constexpr size_t WT_IN = 0, WT_C1K = (size_t)INP * DM * 2, WT_C1V = WT_C1K + 256 * 4096 * 2;
constexpr size_t W2_UPF = 0, W2_UPN = 2048 * 1024 * 2, W2_OUT = 2 * 2048 * 1024 * 2;
constexpr size_t WT_GU = 0, WT_DOWN = (size_t)2 * FFH * DM * 2;
constexpr size_t WS_ABUF = WS_WT + 70 * 1024 * 1024;
constexpr size_t WS_PROJ = WS_ABUF + (size_t)NTOK * DM * 2;
constexpr size_t SZ_HM = (size_t)NTOK * 1024 * 2;
constexpr size_t SZ_KV = (size_t)NTOK * 256 * 2;
constexpr size_t PJ_FQ = 0, PJ_FK = SZ_HM, PJ_FV = 2 * SZ_HM, PJ_NQ = 3 * SZ_HM, PJ_KV = 4 * SZ_HM;
constexpr size_t PJ_GF = PJ_KV + 6 * SZ_KV, PJ_GN = PJ_GF + (size_t)NTOK * DM * 2, PJ_END = PJ_GN + (size_t)NTOK * DM * 2;
constexpr size_t WS_OATT = WS_PROJ + PJ_END;
constexpr size_t WS_Y = WS_OATT + (size_t)NTOK * DM * 2;
constexpr size_t WS_WT2 = WS_Y + (size_t)NTOK * DM * 2;
constexpr size_t WS_END = WS_WT2 + (size_t)2 * 2048 * 1024 * 2 + (size_t)2048 * 2048 * 2;
static_assert((size_t)NTOK * FFH * 2 <= PJ_END, "h fits in proj");

struct Params {
  const float* x; const float* n_mix_pre; const float* n_mix_post; const float* n_ffn_pre; const float* n_ffn_post;
  const float* w_in; const float* f_bias; const float* ck_pe; const float* ck_w1; const float* ck_w2;
  const float* cv_pe; const float* cv_w1; const float* cv_w2; const float* w_up_fox; const float* w_up_nsa;
  const float* w_out; const float* w_gate; const float* w_up; const float* w_down;
  float* out; unsigned char* ws;
};

__constant__ float INVF[16] = {1.0f, 0.44036659598350525f, 0.1939227432012558f, 0.08539710193872452f, 0.03760603070259094f, 0.01656043902039528f,
  0.007292664609849453f, 0.0032114458736032248f, 0.0014142135623842478f, 0.000622772378847003f, 0.00027424818836152554f, 0.00012076973507646471f,
  5.318296098266728e-05f, 2.34199997066753e-05f, 1.0313386155758053e-05f, 4.541670477919979e-06f};

__device__ __forceinline__ int launder_v(int x) { asm volatile("" : "+v"(x)); return x; }
__device__ __forceinline__ int launder_s(int x) { asm volatile("" : "+s"(x)); return x; }
#define LAUNDER_IDS const int tix = launder_v((int)threadIdx.x); const int bix = launder_s((int)blockIdx.x); (void)tix; (void)bix;
__device__ __forceinline__ unsigned cvtpk(float lo, float hi) { unsigned r; asm volatile("s_nop 0\n\tv_cvt_pk_bf16_f32 %0, %1, %2" : "=v"(r) : "v"(lo), "v"(hi)); return r; }
__device__ __forceinline__ float bf2f(unsigned short b) { return __uint_as_float(((unsigned)b) << 16); }
__device__ __forceinline__ float bflo(unsigned w) { return __uint_as_float(w << 16); }
__device__ __forceinline__ float bfhi(unsigned w) { return __uint_as_float(w & 0xffff0000u); }
__device__ __forceinline__ float sigmoidf_(float x) { return __builtin_amdgcn_rcpf(1.f + __expf(-x)); }
__device__ __forceinline__ float wave_sum(float v) {
#pragma unroll
  for (int o = 32; o >= 1; o >>= 1) v += __shfl_xor(v, o);
  return v;
}

constexpr int BM = 256, BK = 64, HALF = 128, HTB = HALF * BK * 2, STAGE_BYTES = 8 * HTB, NXCD = 8, WGM = 8;
__device__ __forceinline__ int lds_byte(int r, int c) { const int st = (r >> 4) * 2 + (c >> 5), rr = r & 15, cc = c & 31, ob = rr * 64 + cc * 2; return st * 1024 + (ob ^ (((ob >> 9) & 1) << 5)); }
__device__ __forceinline__ void stage_rc(int b, int& R, int& C) { const int st = b / 1024, sb = b % 1024, swz = sb ^ (((sb >> 9) & 1) << 5); R = (st >> 1) * 16 + swz / 64; C = (st & 1) * 32 + (swz % 64) / 2; }
__device__ __forceinline__ int perm32(int rho) { const int n = rho >> 4, i = rho & 15; return 8 * (i >> 2) + 4 * n + (i & 3); }

struct Unit { int pm, pn, z; };
struct StaticOrder {
  const bf16_t* A; const bf16_t* Bt; int lda, ldb; int nM, nN, nwg, G, c;
  __device__ void init(const bf16_t* A_, const bf16_t* B_, int lda_, int ldb_, int M, int N) {
  LAUNDER_IDS A = A_; Bt = B_; lda = lda_; ldb = ldb_; nM = M / BM; nN = N / BM; nwg = nM * nN; G = gridDim.x; c = ((bix & 31) << 3) | (bix >> 5); }
  __device__ bool next(int i, Unit& u) const {
    const long L = (long)i * G + c; if (L >= nwg) return false;
    int wgid = (int)L; { const int q = nwg / NXCD, r = nwg % NXCD, xcd = wgid % NXCD, off = wgid / NXCD; wgid = (xcd < r ? xcd * (q + 1) : r * (q + 1) + (xcd - r) * q) + off; }
    const int nig = WGM * nN, gid = wgid / nig, fm = gid * WGM, gsz = (nM - fm) < WGM ? (nM - fm) : WGM;
    u.pm = fm + ((wgid % nig) % gsz); u.pn = (wgid % nig) / gsz; u.z = 0; return true;
  }
  __device__ const char* aptr(const Unit& u) const { return (const char*)(A + (size_t)u.pm * BM * lda); }
  __device__ const char* bptr(const Unit& u) const { return (const char*)(Bt + (size_t)u.pn * BM * ldb); }
};
struct CatOrder {
  StaticOrder base; const bf16_t* B1;
  __device__ bool next(int i, Unit& u) const { if (!base.next(i >> 1, u)) return false; u.z = i & 1; return true; }
  __device__ const char* aptr(const Unit& u) const { return (const char*)(base.A + (size_t)u.pm * BM * base.lda + u.z * 1024); }
  __device__ const char* bptr(const Unit& u) const { return (const char*)((u.z ? B1 : base.Bt) + (size_t)u.pn * BM * base.ldb); }
};
struct CmpOrder {
  const bf16_t* A0; const bf16_t* A1; const bf16_t* B0; const bf16_t* B1; int G, c;
  __device__ bool next(int i, Unit& u) const { const int L = i * G + c; if (L >= 256) return false; u.z = (L >> 7) * 16 + (L & 15); u.pm = (L >> 4) & 7; u.pn = 0; return true; }
  __device__ const char* aptr(const Unit& u) const { return (const char*)(((u.z >> 4) ? A1 : A0) + (size_t)u.pm * BM * 2048 + (u.z & 15) * 256); }
  __device__ const char* bptr(const Unit& u) const { return (const char*)(((u.z >> 4) ? B1 : B0) + (u.z & 15) * 256); }
};

template <class Epi, class Sched>
__device__ __forceinline__ void gemm_phase(LAS unsigned char* lds, const int lda, const int ldb, const int K, const Sched& S, const Epi& E) {
  LAUNDER_IDS
  const int tid = tix, wid = __builtin_amdgcn_readfirstlane(tid >> 6), lane = tid & 63, wr = wid >> 2, wc = wid & 3, fr = lane & 15, fq = lane >> 4;
  const int nt = K / BK;
  unsigned voffA[2], voffB[2];
#pragma unroll
  for (int i = 0; i < 2; ++i) { int R, C; stage_rc(tid * 16 + i * 8192, R, C); const int Rb = Epi::PERM ? ((R & ~31) + perm32(R & 31)) : R;
    voffA[i] = (unsigned)(R * lda + C) * 2u; voffB[i] = (unsigned)(Rb * ldb + C) * 2u; }
  const size_t kstep = (size_t)(BK * 2);
  const size_t hstepA = (size_t)HALF * lda * 2, hstepB = (size_t)HALF * ldb * 2;
  const unsigned ldsw = (unsigned)wid * 1024u;
  const int aoff = lds_byte(wr * 64 + fr, fq * 8), boff = lds_byte(wc * 32 + fr, fq * 8);
#define PG8_SA(b, h) (((b) * 2 + (h)) * HTB)
#define PG8_SB(b, h) ((4 + (b) * 2 + (h)) * HTB)
#define PG8_STAGE(bufoff, gbase, voff) do { _Pragma("unroll") for (int _i = 0; _i < 2; ++_i) { unsigned _vo = (voff)[_i]; asm volatile("" : "+v"(_vo)); \
    __builtin_amdgcn_global_load_lds((const unsigned*)((const char*)(gbase) + _vo), (LAS unsigned*)(lds + (bufoff) + ldsw + _i * 8192), 16, 0, 0); } } while (0)
#define PG8_LDA(dst, b, h) do { _Pragma("unroll") for (int m = 0; m < 4; ++m) _Pragma("unroll") for (int k = 0; k < 2; ++k) dst[m][k] = *(const LAS bf16x8*)(lds + PG8_SA(b, h) + aoff + m * 2048 + k * 1024); } while (0)
#define PG8_LDB(dst, b, h) do { _Pragma("unroll") for (int n = 0; n < 2; ++n) _Pragma("unroll") for (int k = 0; k < 2; ++k) dst[n][k] = *(const LAS bf16x8*)(lds + PG8_SB(b, h) + boff + n * 2048 + k * 1024); } while (0)
#define PG8_MMA(ai, bj, At, Bt) do { __builtin_amdgcn_s_setprio(1); _Pragma("unroll") for (int m = 0; m < 4; ++m) _Pragma("unroll") for (int n = 0; n < 2; ++n) _Pragma("unroll") for (int k = 0; k < 2; ++k) \
    acc[ai][bj][m][n] = __builtin_amdgcn_mfma_f32_16x16x32_bf16(Bt[n][k], At[m][k], acc[ai][bj][m][n], 0, 0, 0); __builtin_amdgcn_s_setprio(0); } while (0)
#define PG8_WAIT_V(n) asm volatile("s_waitcnt vmcnt(" #n ")" ::: "memory")
#define PG8_WAIT_L(n) asm volatile("s_waitcnt lgkmcnt(" #n ")" ::: "memory")
#define PG8_BAR __builtin_amdgcn_s_barrier()
#define PG8_SCHED __builtin_amdgcn_sched_barrier(0)
  Unit cur, nxt; int ui = 0;
  if (!S.next(0, cur)) return;
  f32x4 acc[2][2][4][2];
#pragma unroll
  for (int a = 0; a < 2; ++a)
#pragma unroll
    for (int b = 0; b < 2; ++b)
#pragma unroll
      for (int m = 0; m < 4; ++m)
#pragma unroll
        for (int n = 0; n < 2; ++n) acc[a][b][m][n] = (f32x4){0.f, 0.f, 0.f, 0.f};
  bf16x8 At[4][2], B0[2][2], B1[2][2];
  const char* cA = S.aptr(cur); const char* cB = S.bptr(cur);
  PG8_STAGE(PG8_SB(0, 0), cB, voffB); PG8_STAGE(PG8_SB(0, 1), cB + hstepB, voffB); PG8_STAGE(PG8_SA(0, 0), cA, voffA); PG8_STAGE(PG8_SA(0, 1), cA + hstepA, voffA);
  if (wr == 1) PG8_BAR;
  PG8_WAIT_V(2); PG8_BAR;
  PG8_STAGE(PG8_SB(1, 0), cB + kstep, voffB); PG8_STAGE(PG8_SA(1, 0), cA + kstep, voffA); PG8_STAGE(PG8_SB(1, 1), cB + hstepB + kstep, voffB);
  PG8_WAIT_V(6); PG8_BAR;
  for (;;) {
    const bool has_next = S.next(ui + 1, nxt);
    const char* nA = has_next ? S.aptr(nxt) : cA; const char* nB = has_next ? S.bptr(nxt) : cB;
    for (int t = 0; t < nt; t += 2) {
      const bool last = (t == nt - 2);
      const char* a1 = cA + (size_t)(t + 1) * kstep;
      const char* a2 = last ? nA : cA + (size_t)(t + 2) * kstep; const char* b2 = last ? nB : cB + (size_t)(t + 2) * kstep;
      const char* a3 = a2 + kstep; const char* b3 = b2 + kstep;
      PG8_LDB(B0, 0, 0); PG8_LDB(B1, 0, 1); PG8_SCHED; PG8_LDA(At, 0, 0); PG8_STAGE(PG8_SA(1, 1), a1 + hstepA, voffA);
      PG8_WAIT_V(8); PG8_WAIT_L(0); PG8_BAR; PG8_MMA(0, 0, At, B0); PG8_MMA(0, 1, At, B1); PG8_BAR; PG8_SCHED;
      PG8_LDA(At, 0, 1); PG8_STAGE(PG8_SB(0, 0), b2, voffB); PG8_STAGE(PG8_SB(0, 1), b2 + hstepB, voffB); PG8_STAGE(PG8_SA(0, 0), a2, voffA);
      PG8_WAIT_V(8); PG8_WAIT_L(0); PG8_BAR; PG8_MMA(1, 0, At, B0); PG8_MMA(1, 1, At, B1); PG8_BAR; PG8_SCHED;
      PG8_LDB(B0, 1, 0); PG8_LDB(B1, 1, 1); PG8_SCHED; PG8_LDA(At, 1, 0); PG8_STAGE(PG8_SA(0, 1), a2 + hstepA, voffA);
      PG8_WAIT_V(8); PG8_WAIT_L(0); PG8_BAR; PG8_MMA(0, 0, At, B0); PG8_MMA(0, 1, At, B1); PG8_BAR; PG8_SCHED;
      PG8_LDA(At, 1, 1); PG8_STAGE(PG8_SB(1, 0), b3, voffB); PG8_STAGE(PG8_SB(1, 1), b3 + hstepB, voffB); PG8_STAGE(PG8_SA(1, 0), a3, voffA);
      PG8_WAIT_V(8); PG8_WAIT_L(0); PG8_BAR; PG8_MMA(1, 0, At, B0); PG8_MMA(1, 1, At, B1); PG8_BAR; PG8_SCHED;
    }
    if (wr == 0) PG8_BAR;
    bool keep = false;
    if constexpr (Epi::MID) { if (cur.z == 0) { E.mid(acc, cur, wr, wc, fr, fq); keep = true; } else E(acc, cur, wr, wc, fr, fq); } else E(acc, cur, wr, wc, fr, fq);
    if (!has_next) break;
    if (!keep)
#pragma unroll
    for (int a = 0; a < 2; ++a)
#pragma unroll
      for (int b = 0; b < 2; ++b)
#pragma unroll
        for (int m = 0; m < 4; ++m)
#pragma unroll
          for (int n = 0; n < 2; ++n) acc[a][b][m][n] = (f32x4){0.f, 0.f, 0.f, 0.f};
    cur = nxt; cA = nA; cB = nB; ++ui;
    if (wr == 1) PG8_BAR;
  }
  PG8_WAIT_V(0);
  PG8_BAR;
#undef PG8_SA
#undef PG8_SB
#undef PG8_STAGE
#undef PG8_LDA
#undef PG8_LDB
#undef PG8_MMA
#undef PG8_WAIT_V
#undef PG8_WAIT_L
#undef PG8_BAR
#undef PG8_SCHED
}

typedef const f32x4 (&AccRef)[2][2][4][2];
typedef f32x4 (&MutAccRef)[2][2][4][2];

struct EpiIn {
  static constexpr bool PERM = true, MID = false;
  unsigned char* proj; float* small; const float* ropeq;
  __device__ __forceinline__ void operator()(AccRef acc, const Unit& u, int wr, int wc, int fr, int fq) const {
    const int pn = u.pn; const int row0 = u.pm * BM + wr * 64 + fr; const int col8 = wc * 32 + 8 * fq;
    if (pn < 22) {
      const bool rope = (wc == 0) && ((pn >= 12 && pn < 16) || pn == 18 || pn == 20);
      if (rope) {
#pragma unroll
        for (int ai = 0; ai < 2; ++ai) {
          f32x4 cs[4][2], sn[4][2];
#pragma unroll
          for (int m = 0; m < 4; ++m) { const int t = (row0 + ai * HALF + m * 16) & 4095; const float* rc = ropeq + t * 16 + 8 * (fq & 1);
            cs[m][0] = *(const f32x4*)rc; cs[m][1] = *(const f32x4*)(rc + 4); sn[m][0] = *(const f32x4*)(rc + 65536); sn[m][1] = *(const f32x4*)(rc + 65536 + 4); }
#pragma unroll
          for (int m = 0; m < 4; ++m) {
            const int row = row0 + ai * HALF + m * 16; const int b = row >> 12, t = row & 4095;
#pragma unroll
            for (int bj = 0; bj < 2; ++bj) {
              f32x4 v0 = acc[ai][bj][m][0], v1 = acc[ai][bj][m][1];
              f32x4 p0, p1;
#pragma unroll
              for (int j = 0; j < 4; ++j) { p0[j] = __shfl_xor(v0[j], 32); p1[j] = __shfl_xor(v1[j], 32); }
              const float sg = (fq < 2) ? -1.f : 1.f;
#pragma unroll
              for (int j = 0; j < 4; ++j) { v0[j] = v0[j] * cs[m][0][j] + sg * p0[j] * sn[m][0][j]; v1[j] = v1[j] * cs[m][1][j] + sg * p1[j] * sn[m][1][j]; }
              bf16_t* dst;
              if (pn < 16) { const int head = (pn & 3) * 2 + bj; dst = (bf16_t*)(proj + (size_t)(pn >> 2) * SZ_HM) + ((size_t)(b * 8 + head) * 4096 + t) * 128 + col8; }
              else { dst = (bf16_t*)(proj + PJ_KV + (size_t)(pn - 16) * SZ_KV) + ((size_t)(b * 2 + bj) * 4096 + t) * 128 + col8; }
              u32x4 w; w.x = cvtpk(v0[0], v0[1]); w.y = cvtpk(v0[2], v0[3]); w.z = cvtpk(v1[0], v1[1]); w.w = cvtpk(v1[2], v1[3]);
              *(u32x4*)dst = w;
            }
          }
        }
      } else {
#pragma unroll
        for (int ai = 0; ai < 2; ++ai)
#pragma unroll
          for (int m = 0; m < 4; ++m) {
            const int row = row0 + ai * HALF + m * 16; const int b = row >> 12, t = row & 4095;
#pragma unroll
            for (int bj = 0; bj < 2; ++bj) {
              const f32x4 v0 = acc[ai][bj][m][0], v1 = acc[ai][bj][m][1];
              bf16_t* dst;
              if (pn < 16) { const int head = (pn & 3) * 2 + bj; dst = (bf16_t*)(proj + (size_t)(pn >> 2) * SZ_HM) + ((size_t)(b * 8 + head) * 4096 + t) * 128 + col8; }
              else { dst = (bf16_t*)(proj + PJ_KV + (size_t)(pn - 16) * SZ_KV) + ((size_t)(b * 2 + bj) * 4096 + t) * 128 + col8; }
              u32x4 w; w.x = cvtpk(v0[0], v0[1]); w.y = cvtpk(v0[2], v0[3]); w.z = cvtpk(v1[0], v1[1]); w.w = cvtpk(v1[2], v1[3]);
              *(u32x4*)dst = w;
            }
          }
      }
    } else if (pn < 38) {
      bf16_t* gb = (bf16_t*)(proj + (pn < 30 ? PJ_GF : PJ_GN)); const int colt = ((pn - 22) & 7) * 256 + col8;
#pragma unroll
      for (int ai = 0; ai < 2; ++ai)
#pragma unroll
        for (int m = 0; m < 4; ++m) {
          const int row = row0 + ai * HALF + m * 16;
#pragma unroll
          for (int bj = 0; bj < 2; ++bj) {
            f32x4 v0 = acc[ai][bj][m][0], v1 = acc[ai][bj][m][1];
#pragma unroll
            for (int j = 0; j < 4; ++j) { v0[j] = sigmoidf_(v0[j]); v1[j] = sigmoidf_(v1[j]); }
            u32x4 w; w.x = cvtpk(v0[0], v0[1]); w.y = cvtpk(v0[2], v0[3]); w.z = cvtpk(v1[0], v1[1]); w.w = cvtpk(v1[2], v1[3]);
            *(u32x4*)(gb + (size_t)row * DM + colt + bj * HALF) = w;
          }
        }
    } else {
      if (wc == 0) {
#pragma unroll
        for (int ai = 0; ai < 2; ++ai)
#pragma unroll
          for (int m = 0; m < 4; ++m) {
            const int row = row0 + ai * HALF + m * 16;
            float* d = small + (size_t)row * 32 + 8 * fq;
            *(f32x4*)d = acc[ai][0][m][0]; *(f32x4*)(d + 4) = acc[ai][0][m][1];
          }
      }
    }
  }
};

struct EpiPartial {
  static constexpr bool PERM = true, MID = false;
  bf16_t* out;
  __device__ __forceinline__ void operator()(AccRef acc, const Unit& u, int wr, int wc, int fr, int fq) const {
    const int row0 = u.pm * BM + wr * 64 + fr, col0 = wc * 32 + 8 * fq;
    bf16_t* base = out + (size_t)u.z * 2048 * 256;
#pragma unroll
    for (int ai = 0; ai < 2; ++ai)
#pragma unroll
      for (int m = 0; m < 4; ++m) { bf16_t* rowp = base + (size_t)(row0 + ai * HALF + m * 16) * 256 + col0;
#pragma unroll
        for (int bj = 0; bj < 2; ++bj) { const f32x4 v0 = acc[ai][bj][m][0], v1 = acc[ai][bj][m][1];
          u32x4 w; w.x = cvtpk(v0[0], v0[1]); w.y = cvtpk(v0[2], v0[3]); w.z = cvtpk(v1[0], v1[1]); w.w = cvtpk(v1[2], v1[3]);
          *(u32x4*)(rowp + bj * HALF) = w; } }
  }
};

struct EpiUpCat {
  static constexpr bool PERM = true, MID = true;
  const bf16_t* gf; const bf16_t* gn; bf16_t* mix;
  __device__ __forceinline__ void mid(MutAccRef acc, const Unit& u, int wr, int wc, int fr, int fq) const {
    const int row0 = u.pm * BM + wr * 64 + fr; const int col0 = u.pn * BM + wc * 32 + 8 * fq;
#pragma unroll
    for (int ai = 0; ai < 2; ++ai) {
      u32x4 a[4][2], b[4][2];
#pragma unroll
      for (int m = 0; m < 4; ++m)
#pragma unroll
        for (int bj = 0; bj < 2; ++bj) { const size_t ro = (size_t)(row0 + ai * HALF + m * 16) * DM + col0 + bj * HALF; a[m][bj] = *(const u32x4*)(gf + ro); b[m][bj] = *(const u32x4*)(gn + ro); }
#pragma unroll
      for (int m = 0; m < 4; ++m)
#pragma unroll
        for (int bj = 0; bj < 2; ++bj) { const u32x4 x = a[m][bj], y = b[m][bj];
          acc[ai][bj][m][0][0] *= bflo(x.x) * __builtin_amdgcn_rcpf(bflo(y.x)); acc[ai][bj][m][0][1] *= bfhi(x.x) * __builtin_amdgcn_rcpf(bfhi(y.x));
          acc[ai][bj][m][0][2] *= bflo(x.y) * __builtin_amdgcn_rcpf(bflo(y.y)); acc[ai][bj][m][0][3] *= bfhi(x.y) * __builtin_amdgcn_rcpf(bfhi(y.y));
          acc[ai][bj][m][1][0] *= bflo(x.z) * __builtin_amdgcn_rcpf(bflo(y.z)); acc[ai][bj][m][1][1] *= bfhi(x.z) * __builtin_amdgcn_rcpf(bfhi(y.z));
          acc[ai][bj][m][1][2] *= bflo(x.w) * __builtin_amdgcn_rcpf(bflo(y.w)); acc[ai][bj][m][1][3] *= bfhi(x.w) * __builtin_amdgcn_rcpf(bfhi(y.w)); }
    }
  }
  __device__ __forceinline__ void operator()(AccRef acc, const Unit& u, int wr, int wc, int fr, int fq) const {
    const int row0 = u.pm * BM + wr * 64 + fr; const int col0 = u.pn * BM + wc * 32 + 8 * fq;
#pragma unroll
    for (int ai = 0; ai < 2; ++ai) {
      u32x4 b[4][2];
#pragma unroll
      for (int m = 0; m < 4; ++m)
#pragma unroll
        for (int bj = 0; bj < 2; ++bj) { const size_t ro = (size_t)(row0 + ai * HALF + m * 16) * DM + col0 + bj * HALF; b[m][bj] = *(const u32x4*)(gn + ro); }
#pragma unroll
      for (int m = 0; m < 4; ++m)
#pragma unroll
        for (int bj = 0; bj < 2; ++bj) { const size_t ro = (size_t)(row0 + ai * HALF + m * 16) * DM + col0 + bj * HALF; const u32x4 y = b[m][bj];
          const f32x4 v0 = acc[ai][bj][m][0], v1 = acc[ai][bj][m][1];
          u32x4 w; w.x = cvtpk(v0[0] * bflo(y.x), v0[1] * bfhi(y.x)); w.y = cvtpk(v0[2] * bflo(y.y), v0[3] * bfhi(y.y)); w.z = cvtpk(v1[0] * bflo(y.z), v1[1] * bfhi(y.z)); w.w = cvtpk(v1[2] * bflo(y.w), v1[3] * bfhi(y.w));
          *(u32x4*)(mix + ro) = w; }
    }
  }
};

struct EpiY {
  static constexpr bool PERM = true, MID = false;
  bf16_t* y; float* ssq;
  __device__ __forceinline__ void operator()(AccRef acc, const Unit& u, int wr, int wc, int fr, int fq) const {
    const int row0 = u.pm * BM + wr * 64 + fr; const int col0 = u.pn * BM + wc * 32 + 8 * fq;
#pragma unroll
    for (int ai = 0; ai < 2; ++ai)
#pragma unroll
      for (int m = 0; m < 4; ++m) {
        const int row = row0 + ai * HALF + m * 16; float s = 0.f;
#pragma unroll
        for (int bj = 0; bj < 2; ++bj) {
          const f32x4 v0 = acc[ai][bj][m][0], v1 = acc[ai][bj][m][1];
#pragma unroll
          for (int j = 0; j < 4; ++j) s += v0[j] * v0[j] + v1[j] * v1[j];
          u32x4 w; w.x = cvtpk(v0[0], v0[1]); w.y = cvtpk(v0[2], v0[3]); w.z = cvtpk(v1[0], v1[1]); w.w = cvtpk(v1[2], v1[3]);
          *(u32x4*)(y + (size_t)row * DM + col0 + bj * HALF) = w;
        }
        s += __shfl_xor(s, 16); s += __shfl_xor(s, 32);
        if (fq == 0) ssq[(size_t)row * 32 + u.pn * 4 + wc] = s;
      }
  }
};

struct EpiSwiglu {
  static constexpr bool PERM = true, MID = false;
  bf16_t* h;
  __device__ __forceinline__ void operator()(AccRef acc, const Unit& u, int wr, int wc, int fr, int fq) const {
    const int row0 = u.pm * BM + wr * 64 + fr; const int col0 = u.pn * HALF + wc * 32 + 8 * fq;
#pragma unroll
    for (int ai = 0; ai < 2; ++ai)
#pragma unroll
      for (int m = 0; m < 4; ++m) {
        const int row = row0 + ai * HALF + m * 16;
        float r[8];
#pragma unroll
        for (int n = 0; n < 2; ++n)
#pragma unroll
          for (int j = 0; j < 4; ++j) { const float g = acc[ai][0][m][n][j], up = acc[ai][1][m][n][j]; r[n * 4 + j] = g * sigmoidf_(g) * up; }
        u32x4 w; w.x = cvtpk(r[0], r[1]); w.y = cvtpk(r[2], r[3]); w.z = cvtpk(r[4], r[5]); w.w = cvtpk(r[6], r[7]);
        *(u32x4*)(h + (size_t)row * FFH + col0) = w;
      }
  }
};

__device__ __forceinline__ int inmap(int n) {
  if (n < 3072) return n;
  if (n < 4096) return n + 8;
  if (n < 5632) return n + 8;
  if (n < 9728) return n + 32;
  if (n < 9736) return n - 9728 + 3072;
  if (n < 9760) return n - 9736 + 5640;
  return -1;
}
template <int MAP>
__device__ __forceinline__ void conv_tile(const float* src, int ld, const float* src2, bf16_t* dst, int K, int n0, int k0, float* tl) {
  LAUNDER_IDS
  const int tid = tix;
  { const int r = tid >> 4, c4 = (tid & 15) * 4;
    f32x4 v[4][2];
#pragma unroll
    for (int cg = 0; cg < 4; ++cg) {
      const int n = n0 + cg * 64 + c4; const float* s = src; int sc;
      if (MAP == 1) sc = inmap(n);
      else if (MAP == 2) { const int j = n >> 8, w = n & 255; if (w < 128) { sc = j * 128 + w; } else { sc = j * 128 + w - 128; s = src2; } }
      else sc = n;
#pragma unroll
      for (int h = 0; h < 2; ++h) { v[cg][h] = (f32x4){0.f, 0.f, 0.f, 0.f}; if (sc >= 0) v[cg][h] = *(const f32x4*)(s + (size_t)(k0 + r + h * 32) * ld + sc); }
    }
#pragma unroll
    for (int cg = 0; cg < 4; ++cg)
#pragma unroll
      for (int h = 0; h < 2; ++h) { float* d = tl + (r + h * 32) * 257 + cg * 64 + c4; d[0] = v[cg][h][0]; d[1] = v[cg][h][1]; d[2] = v[cg][h][2]; d[3] = v[cg][h][3]; }
  }
  __syncthreads();
#pragma unroll
  for (int it = 0; it < 4; ++it) { const int idx = it * NTHR + tid, q = idx & 7, n = idx >> 3;
    float v[8];
#pragma unroll
    for (int j = 0; j < 8; ++j) v[j] = tl[(q * 8 + j) * 257 + n];
    u32x4 w; w.x = cvtpk(v[0], v[1]); w.y = cvtpk(v[2], v[3]); w.z = cvtpk(v[4], v[5]); w.w = cvtpk(v[6], v[7]);
    *(u32x4*)(dst + (size_t)(n0 + n) * K + k0 + q * 8) = w;
  }
  __syncthreads();
}
__device__ __forceinline__ void convert_mixer(const Params& p, int l, float* tl) {
  LAUNDER_IDS
  unsigned char* wt = p.ws + WS_WT;
  const float* w_in = p.w_in + (size_t)l * DM * INW;
  const float* wuf = p.w_up_fox + (size_t)l * 1024 * DM; const float* wun = p.w_up_nsa + (size_t)l * 1024 * DM;
  const float* wo = p.w_out + (size_t)l * DM * DM;
  const float* c1k = p.ck_w1 + (size_t)l * 4096 * 256; const float* c1v = p.cv_w1 + (size_t)l * 4096 * 256;
  constexpr int T_IN = 32 * 39, T_UP = 16 * 8, T_OUT = 32 * 8, T_C1 = 64;
  constexpr int TOTAL = T_IN + 2 * T_UP + T_OUT + 2 * T_C1;
  for (int j = bix; j < TOTAL; j += gridDim.x) {
    int q = j;
    if (q < T_IN) { conv_tile<1>(w_in, INW, nullptr, (bf16_t*)(wt + WT_IN), DM, (q / 32) * 256, (q % 32) * 64, tl); continue; } q -= T_IN;
    if (q < T_UP) { conv_tile<0>(wuf, DM, nullptr, (bf16_t*)(p.ws + WS_WT2 + W2_UPF), 1024, (q / 16) * 256, (q % 16) * 64, tl); continue; } q -= T_UP;
    if (q < T_UP) { conv_tile<0>(wun, DM, nullptr, (bf16_t*)(p.ws + WS_WT2 + W2_UPN), 1024, (q / 16) * 256, (q % 16) * 64, tl); continue; } q -= T_UP;
    if (q < T_OUT) { conv_tile<0>(wo, DM, nullptr, (bf16_t*)(p.ws + WS_WT2 + W2_OUT), DM, (q / 32) * 256, (q % 32) * 64, tl); continue; } q -= T_OUT;
    if (q < T_C1) { conv_tile<0>(c1k, 256, nullptr, (bf16_t*)(wt + WT_C1K), 4096, 0, q * 64, tl); continue; } q -= T_C1;
    conv_tile<0>(c1v, 256, nullptr, (bf16_t*)(wt + WT_C1V), 4096, 0, q * 64, tl);
  }
  float* peb = (float*)(p.ws + WS_PEB);
  for (int j = bix; j < 64; j += gridDim.x) {
    const int mat = j >> 5, sl = j & 31; const float* pe = (mat ? p.cv_pe : p.ck_pe) + (size_t)l * 4096 + sl * 128; const float* w1 = (mat ? c1v : c1k) + (size_t)sl * 128 * 256;
    if (tix < 256) { float s = 0.f;
#pragma unroll 8
      for (int kk = 0; kk < 128; ++kk) s += pe[kk] * w1[kk * 256 + tix]; peb[(mat * 32 + sl) * 256 + tix] = s; }
  }
}
constexpr int T_FFN_GU = 32 * 44, T_FFN_DN = 88 * 8, T_FFN = T_FFN_GU + T_FFN_DN;
__device__ __forceinline__ void convert_ffn_tile(const Params& p, int l, int j, float* tl) {
  unsigned char* wt = p.ws + WS_WT;
  const float* wg = p.w_gate + (size_t)l * DM * FFH; const float* wu = p.w_up + (size_t)l * DM * FFH; const float* wd = p.w_down + (size_t)l * FFH * DM;
  if (j < T_FFN_GU) conv_tile<2>(wg, FFH, wu, (bf16_t*)(wt + WT_GU), DM, (j / 32) * 256, (j % 32) * 64, tl);
  else { const int q = j - T_FFN_GU; conv_tile<0>(wd, DM, nullptr, (bf16_t*)(wt + WT_DOWN), FFH, (q / 88) * 256, (q % 88) * 64, tl); }
}

__device__ __forceinline__ void row_phase(int mode, const float* xin, float* xout, const bf16_t* __restrict__ y, const float* __restrict__ ssq, const float* __restrict__ g_post, const float* __restrict__ g_next, bf16_t* __restrict__ abuf) {
  LAUNDER_IDS
  const int lane = tix & 63, gw = bix * 8 + (tix >> 6), nw = gridDim.x * 8;
  for (int row = gw; row < NTOK; row += nw) {
    f32x4 v[8];
    const float* xr = xin + (size_t)row * DM;
#pragma unroll
    for (int i = 0; i < 8; ++i) v[i] = *(const f32x4*)(xr + (i * 64 + lane) * 4);
    if (mode == 1) {
      u32x2 yy[8]; f32x4 g[8];
      const bf16_t* yr = y + (size_t)row * DM;
      float sp = (lane < 32) ? ssq[(size_t)row * 32 + lane] : 0.f;
#pragma unroll
      for (int i = 0; i < 8; ++i) { const int c = (i * 64 + lane) * 4; yy[i] = *(const u32x2*)(yr + c); g[i] = *(const f32x4*)(g_post + c); }
      sp = wave_sum(sp);
      const float rs = rsqrtf(sp * (1.f / DM) + EPSN);
#pragma unroll
      for (int i = 0; i < 8; ++i) {
        v[i][0] += bflo(yy[i].x) * rs * g[i][0]; v[i][1] += bfhi(yy[i].x) * rs * g[i][1]; v[i][2] += bflo(yy[i].y) * rs * g[i][2]; v[i][3] += bfhi(yy[i].y) * rs * g[i][3]; }
#pragma unroll
      for (int i = 0; i < 8; ++i) *(f32x4*)(xout + (size_t)row * DM + (i * 64 + lane) * 4) = v[i];
    }
    if (g_next) {
      f32x4 g[8];
#pragma unroll
      for (int i = 0; i < 8; ++i) g[i] = *(const f32x4*)(g_next + (i * 64 + lane) * 4);
      float s = 0.f;
#pragma unroll
      for (int i = 0; i < 8; ++i) s += v[i][0] * v[i][0] + v[i][1] * v[i][1] + v[i][2] * v[i][2] + v[i][3] * v[i][3];
      s = wave_sum(s);
      const float rs = rsqrtf(s * (1.f / DM) + EPSN);
#pragma unroll
      for (int i = 0; i < 8; ++i) { const int c = (i * 64 + lane) * 4;
        u32x2 w; w.x = cvtpk(v[i][0] * rs * g[i][0], v[i][1] * rs * g[i][1]); w.y = cvtpk(v[i][2] * rs * g[i][2], v[i][3] * rs * g[i][3]);
        *(u32x2*)(abuf + (size_t)row * DM + c) = w; }
    }
  }
}

__device__ __forceinline__ void sincos_d(float ang, float& c, float& s) {
  const double x = (double)ang; const double q = rint(x * 0.63661977236758134308);
  double r = fma(-q, 1.57079632679489655800e+00, x); r = fma(-q, 6.12323399573676603587e-17, r);
  const int qi = (int)q; const double r2 = r * r;
  const double sr = r * (1.0 + r2 * (-1.0 / 6 + r2 * (1.0 / 120 + r2 * (-1.0 / 5040 + r2 * (1.0 / 362880 + r2 * (-1.0 / 39916800 + r2 * (1.0 / 6227020800.0)))))));
  const double cr = 1.0 + r2 * (-0.5 + r2 * (1.0 / 24 + r2 * (-1.0 / 720 + r2 * (1.0 / 40320 + r2 * (-1.0 / 3628800 + r2 * (1.0 / 479001600 + r2 * (-1.0 / 87178291200.0)))))));
  double cc, ss;
  switch (qi & 3) { case 0: cc = cr; ss = sr; break; case 1: cc = -sr; ss = cr; break; case 2: cc = -cr; ss = -sr; break; default: cc = sr; ss = -cr; break; }
  c = (float)cc; s = (float)ss;
}
__device__ __forceinline__ void rope_tables(const Params& p) {
  LAUNDER_IDS
  float* rq = (float*)(p.ws + WS_ROPEQ); float* rc = (float*)(p.ws + WS_ROPEC);
  for (int e = bix * NTHR + tix; e < 65536 + 4096; e += gridDim.x * NTHR) {
    if (e < 65536) { const int t = e >> 4, i = e & 15; float c, s; sincos_d((float)t * INVF[i], c, s); rq[e] = c; rq[65536 + e] = s; }
    else { const int e2 = e - 65536, n = e2 >> 4, i = e2 & 15; float c, s; sincos_d((float)(n * 16 + 31) * INVF[i], c, s); rc[e2] = c; rc[4096 + e2] = s; }
  }
}
__device__ __forceinline__ int item_cost(int id) {
  if (id < 512) return 4 * ((id & 15) + 1);
  const int c = (id - 512) & 63; return (c + 1) + (c + 1 < 9 ? c + 1 : 9) + 2 * ((4 * c + 2) / 64 + 1) + 4;
}
__device__ __forceinline__ void sort_items(const Params& p, int* lc) {
  LAUNDER_IDS
  int* order = (int*)(p.ws + WS_ORDER);
  for (int id = tix; id < 1024; id += NTHR) lc[id] = item_cost(id);
  __syncthreads();
  for (int id = tix; id < 1024; id += NTHR) {
    const int mc = lc[id]; int rank = 0;
    for (int o = 0; o < 1024; ++o) { const int oc = lc[o]; rank += (oc > mc) || (oc == mc && o < id); }
    order[rank] = id;
  }
  if (tix < 8) ((unsigned*)(p.ws + WS_CTL))[tix] = 0u;
  if (tix < 64) ((unsigned*)(p.ws + WS_CTL + 256))[tix] = 0u;
  for (int i = tix; i < 4096; i += NTHR) ((unsigned*)(p.ws + WS_BAR))[i] = 0u;
  __syncthreads();
}

__device__ __forceinline__ void cumsum_phase(const Params& p, int l, float* lf) {
  LAUNDER_IDS
  if (bix >= 32) return;
  const int bh = bix, b = bh >> 3, h = bh & 7, lane = tix & 63, w = tix >> 6;
  const float* sm = (const float*)(p.ws + WS_SMALL) + ((size_t)b * 4096 + tix * 8) * 32 + h; const float fb = p.f_bias[l * 8 + h];
  float* cum = (float*)(p.ws + WS_CUM) + bh * 4096 + tix * 8;
  float x[8], v[8]; float run = 0.f;
#pragma unroll
  for (int j = 0; j < 8; ++j) x[j] = sm[j * 32] + fb;
#pragma unroll
  for (int j = 0; j < 8; ++j) { run += fminf(x[j], 0.f) - log1pf(__expf(-fabsf(x[j]))); v[j] = run; }
  float inc = run;
#pragma unroll
  for (int o = 1; o < 64; o <<= 1) { const float n = __shfl_up(inc, o); if (lane >= o) inc += n; }
  if (lane == 63) lf[w] = inc;
  __syncthreads();
  float base = inc - run;
  for (int i = 0; i < w; ++i) base += lf[i];
#pragma unroll
  for (int j = 0; j < 8; ++j) cum[j] = base + v[j];
  __syncthreads();
}

__device__ __forceinline__ void kmax_phase(const Params& p, int l) {
  LAUNDER_IDS
  if (bix < 32 || bix >= 160) return;
  const int part = bix - 32, bh = part >> 2, q4 = part & 3;
  const bf16_t* K = (const bf16_t*)(p.ws + WS_PROJ + PJ_FK) + ((size_t)bh * 4096 + q4 * 1024) * 128;
  float mx = 0.f;
#pragma unroll 8
  for (int it = 0; it < 32; ++it) { const int idx = it * NTHR + tix;
    const u32x4 v = *(const u32x4*)(K + (size_t)idx * 8);
    float s = bflo(v.x) * bflo(v.x) + bfhi(v.x) * bfhi(v.x) + bflo(v.y) * bflo(v.y) + bfhi(v.y) * bfhi(v.y) + bflo(v.z) * bflo(v.z) + bfhi(v.z) * bfhi(v.z) + bflo(v.w) * bflo(v.w) + bfhi(v.w) * bfhi(v.w);
    s += __shfl_xor(s, 1); s += __shfl_xor(s, 2); s += __shfl_xor(s, 4); s += __shfl_xor(s, 8);
    mx = fmaxf(mx, s); }
#pragma unroll
  for (int o = 32; o >= 1; o >>= 1) mx = fmaxf(mx, __shfl_xor(mx, o));
  if ((tix & 63) == 0) atomicMax((unsigned*)(p.ws + WS_CTL + 256) + l * 32 + bh, __float_as_uint(mx));
}

__device__ __forceinline__ void cmp_finish(const Params& p, int l, float* lf) {
  LAUNDER_IDS
  float* pebs = lf;
  float* hs = lf + 256;
  float* os = lf + 256 + 4096;
  bf16_t* w2s = (bf16_t*)(lf + 256 + 4096 + 2048);
  const bf16_t* part = (const bf16_t*)(p.ws + WS_Y); const float* peb = (const float*)(p.ws + WS_PEB); const float* rc = (const float*)(p.ws + WS_ROPEC);
  const int tid = tix;
  for (int task = bix; task < 256; task += gridDim.x) {
    const int mat = task >> 7, R0 = (task & 127) * 16;
    { const float* w2 = (mat ? p.cv_w2 : p.ck_w2) + (size_t)l * 256 * 128;
      f32x4 w[16];
#pragma unroll
      for (int i = 0; i < 16; ++i) w[i] = *(const f32x4*)(w2 + (i * NTHR + tid) * 4);
#pragma unroll
      for (int i = 0; i < 16; ++i) { u32x2 q; q.x = cvtpk(w[i][0], w[i][1]); q.y = cvtpk(w[i][2], w[i][3]); *(u32x2*)(w2s + (i * NTHR + tid) * 4) = q; } }
    if (tid < 256) { float sl[32];
#pragma unroll
      for (int i = 0; i < 32; ++i) sl[i] = peb[(mat * 32 + i) * 256 + tid];
      float s = 0.f;
#pragma unroll
      for (int i = 0; i < 32; ++i) s += sl[i];
      pebs[tid] = s; }
    __syncthreads();
    { const int r = tid >> 5, c = (tid & 31) * 8; u32x4 q[16];
#pragma unroll
      for (int sp = 0; sp < 16; ++sp) q[sp] = *(const u32x4*)(part + ((size_t)(mat * 16 + sp) * 2048 + R0 + r) * 256 + c);
      float a[8] = {0.f, 0.f, 0.f, 0.f, 0.f, 0.f, 0.f, 0.f};
#pragma unroll
      for (int sp = 0; sp < 16; ++sp) { a[0] += bflo(q[sp].x); a[1] += bfhi(q[sp].x); a[2] += bflo(q[sp].y); a[3] += bfhi(q[sp].y); a[4] += bflo(q[sp].z); a[5] += bfhi(q[sp].z); a[6] += bflo(q[sp].w); a[7] += bfhi(q[sp].w); }
#pragma unroll
      for (int j = 0; j < 8; ++j) { const float x = a[j] + pebs[c + j]; const float u = 0.7978845608028654f * (x + 0.044715f * x * x * x);
        const float th = 1.f - 2.f * __builtin_amdgcn_rcpf(1.f + __expf(2.f * u)); hs[r * 256 + c + j] = 0.5f * x * (1.f + th); } }
    __syncthreads();
    const int r = tid >> 5, n4 = (tid & 31) * 4;
    { f32x4 a = (f32x4){0.f, 0.f, 0.f, 0.f};
#pragma unroll 8
      for (int k = 0; k < 256; ++k) { const float hv = hs[r * 256 + k]; const u32x2 w = *(const u32x2*)(w2s + k * 128 + n4);
        a[0] += hv * bflo(w.x); a[1] += hv * bfhi(w.x); a[2] += hv * bflo(w.y); a[3] += hv * bfhi(w.y); }
      *(f32x4*)(os + r * 128 + n4) = a; }
    __syncthreads();
    { const int R = R0 + r, i = R & 255;
      f32x4 v = *(const f32x4*)(os + r * 128 + n4);
      if (mat == 0 && n4 < 32) { const int f = n4 & 15; const f32x4 cc = *(const f32x4*)(rc + i * 16 + f), ss = *(const f32x4*)(rc + 4096 + i * 16 + f);
        if (n4 < 16) { const f32x4 q = *(const f32x4*)(os + r * 128 + n4 + 16); v = v * cc - q * ss; }
        else { const f32x4 q = *(const f32x4*)(os + r * 128 + n4 - 16); v = v * cc + q * ss; } }
      if (i == 255) v = (f32x4){0.f, 0.f, 0.f, 0.f};
      u32x2 w; w.x = cvtpk(v[0], v[1]); w.y = cvtpk(v[2], v[3]);
      *(u32x2*)((bf16_t*)(p.ws + (mat ? WS_VC : WS_KC)) + (size_t)R * 128 + n4) = w; }
    __syncthreads();
  }
}

constexpr int SHM_V = 64 * 128 * 2, SHM_K = 64 * 128 * 2;
constexpr int AT_SCR = 2 * SHM_V + 2 * SHM_K;
constexpr int AT_CB = AT_SCR + 8 * 64 * 4;
constexpr int AT_IMPU = AT_CB + 2 * 64 * 4;
constexpr int AT_IMPW = AT_IMPU + 8 * 8 * 64 * 4;
constexpr int AT_Q = AT_IMPW + 8 * 8 * 64 * 4;
constexpr int AT_END = AT_Q + 128;
#define KSWZ(row, colB) ((row) * 256 + ((colB) ^ (((row) & 7) << 4)))
#define SBAR() __builtin_amdgcn_sched_barrier(0)
__device__ __forceinline__ int v_st(int k, int c) { const int kk = (k & ~0xC) | ((k & 4) << 1) | ((k & 8) >> 1); return ((kk >> 3) * 4 + (c >> 5)) * 512 + ((kk & 7) * 32 + (c & 31)) * 2; }
__device__ __forceinline__ int v_rd_base(int lane) { return ((lane & 3) << 3) | (((lane >> 2) & 3) << 6) | (((lane >> 4) & 1) << 5) | (((lane >> 5) & 1) << 8); }
constexpr int v_rd_off(int d0, int ks, int half) { return d0 * 512 + ks * 4096 + half * 2048; }
__device__ __forceinline__ int crow(int r, int hi) { return (r & 3) + 8 * (r >> 2) + 4 * hi; }

__device__ __forceinline__ void mask_tile(f32x16& p0, f32x16& p1, int dq, unsigned W) {
  const float NEG = -__builtin_inff();
#pragma unroll
  for (int r = 0; r < 16; ++r) {
    const int c = (r & 3) + 8 * (r >> 2);
    if ((unsigned)(dq - c) >= W) p0[r] = NEG;
    if ((unsigned)(dq - c - 32) >= W) p1[r] = NEG;
  }
}
__device__ __forceinline__ void partialSM(f32x16& p0, f32x16& p1, float& m_reg, float& alpha) {
  float pmax = p0[0];
#pragma unroll
  for (int r = 1; r < 16; ++r) pmax = fmaxf(pmax, p0[r]);
#pragma unroll
  for (int r = 0; r < 16; ++r) pmax = fmaxf(pmax, p1[r]);
  { auto rr = __builtin_amdgcn_permlane32_swap(__float_as_uint(pmax), __float_as_uint(pmax), false, false);
    pmax = fmaxf(__uint_as_float(rr[0]), __uint_as_float(rr[1])); }
  float mn;
  if (__all((pmax - m_reg) <= 11.5f)) { mn = m_reg; alpha = 1.f; }
  else { mn = fmaxf(m_reg, pmax); alpha = __builtin_amdgcn_exp2f(m_reg - mn); m_reg = mn; }
#pragma unroll
  for (int r = 0; r < 16; ++r) p0[r] = __builtin_amdgcn_exp2f(p0[r] - mn);
#pragma unroll
  for (int r = 0; r < 16; ++r) p1[r] = __builtin_amdgcn_exp2f(p1[r] - mn);
}
__device__ __forceinline__ void finishSM(f32x16& p0, f32x16& p1, float alpha, float& l_reg, bf16x8& pa0, bf16x8& pa1, bf16x8& pa2, bf16x8& pa3) {
  float ps = 0;
#pragma unroll
  for (int r = 0; r < 16; ++r) ps += p0[r];
#pragma unroll
  for (int r = 0; r < 16; ++r) ps += p1[r];
  { auto rr = __builtin_amdgcn_permlane32_swap(__float_as_uint(ps), __float_as_uint(ps), false, false);
    ps = __uint_as_float(rr[0]) + __uint_as_float(rr[1]); }
  l_reg = l_reg * alpha + ps;
#define PK4(P, B_, OUT) do { unsigned a0 = cvtpk(P[B_+0], P[B_+1]), a1 = cvtpk(P[B_+2], P[B_+3]);                          \
    unsigned b0 = cvtpk(P[B_+4], P[B_+5]), b1 = cvtpk(P[B_+6], P[B_+7]);                                             \
    auto r0 = __builtin_amdgcn_permlane32_swap(a0, b0, false, false); auto r1 = __builtin_amdgcn_permlane32_swap(a1, b1, false, false); \
    u32x4 w = {r0[0], r1[0], r0[1], r1[1]}; OUT = *reinterpret_cast<bf16x8*>(&w); } while (0)
  PK4(p0, 0, pa0); PK4(p0, 8, pa1); PK4(p1, 0, pa2); PK4(p1, 8, pa3);
#undef PK4
}
template <int MODE>
__device__ __forceinline__ bool partialSM3(f32x16& p0, f32x16& p1, float& m_reg, float& alpha, bool rsel) {
  float pmax = p0[0];
#pragma unroll
  for (int r = 1; r < 16; ++r) pmax = fmaxf(pmax, p0[r]);
#pragma unroll
  for (int r = 0; r < 16; ++r) pmax = fmaxf(pmax, p1[r]);
  { auto rr = __builtin_amdgcn_permlane32_swap(__float_as_uint(pmax), __float_as_uint(pmax), false, false);
    pmax = fmaxf(__uint_as_float(rr[0]), __uint_as_float(rr[1])); }
  if (MODE != 0) pmax *= C2;
  if (MODE == 3 && !rsel) pmax = -__builtin_inff();
  if (MODE == 0) { if (__all(pmax - m_reg < -160.f)) { alpha = 1.f; return true; } }
  float mn;
  if (__all((pmax - m_reg) <= 11.5f)) { mn = m_reg; alpha = 1.f; }
  else { mn = fmaxf(m_reg, pmax); alpha = __builtin_amdgcn_exp2f(m_reg - mn); m_reg = mn; }
  float mnL = -mn;
  if (MODE == 3 && !rsel) mnL = -__builtin_inff();
  if (MODE == 0) {
#pragma unroll
    for (int r = 0; r < 16; ++r) { p0[r] = __builtin_amdgcn_exp2f(p0[r] + mnL); p1[r] = p1[r] + mnL; }
  } else {
#pragma unroll
    for (int r = 0; r < 16; ++r) { p0[r] = __builtin_amdgcn_exp2f(fmaf(p0[r], C2, mnL)); p1[r] = fmaf(p1[r], C2, mnL); }
  }
  return false;
}
__device__ __forceinline__ void finishSM3(f32x16& p0, f32x16& p1, float alpha, float& l_reg, bf16x8& pa0, bf16x8& pa1, bf16x8& pa2, bf16x8& pa3) {
#pragma unroll
  for (int r = 0; r < 16; ++r) p1[r] = __builtin_amdgcn_exp2f(p1[r]);
  float ps = 0;
#pragma unroll
  for (int r = 0; r < 16; ++r) ps += p0[r];
#pragma unroll
  for (int r = 0; r < 16; ++r) ps += p1[r];
  { auto rr = __builtin_amdgcn_permlane32_swap(__float_as_uint(ps), __float_as_uint(ps), false, false);
    ps = __uint_as_float(rr[0]) + __uint_as_float(rr[1]); }
  l_reg = l_reg * alpha + ps;
#define PK4(P, B_, OUT) do { unsigned a0 = cvtpk(P[B_+0], P[B_+1]), a1 = cvtpk(P[B_+2], P[B_+3]);                          \
    unsigned b0 = cvtpk(P[B_+4], P[B_+5]), b1 = cvtpk(P[B_+6], P[B_+7]);                                             \
    auto r0 = __builtin_amdgcn_permlane32_swap(a0, b0, false, false); auto r1 = __builtin_amdgcn_permlane32_swap(a1, b1, false, false); \
    u32x4 w = {r0[0], r1[0], r0[1], r1[1]}; OUT = *reinterpret_cast<bf16x8*>(&w); } while (0)
  PK4(p0, 0, pa0); PK4(p0, 8, pa1); PK4(p1, 0, pa2); PK4(p1, 8, pa3);
#undef PK4
}
template <int KB>
__device__ __forceinline__ void qkt(f32x16& p0, f32x16& p1, const char* K_lds, int r32, int hi, const bf16x8* qr) {
  p0 = f32x16{}; p1 = f32x16{};
  const char* kb[4];
#pragma unroll
  for (int dd = 0; dd < 4; ++dd) kb[dd] = K_lds + KB * SHM_K + KSWZ(r32, (dd * 16 + hi * 8) * 2);
#pragma unroll
  for (int d0 = 0; d0 < 8; ++d0) { const char* a = kb[d0 & 3] + (d0 >> 2) * 128;
    bf16x8 b0 = *reinterpret_cast<const bf16x8*>(a);
    bf16x8 b1 = *reinterpret_cast<const bf16x8*>(a + 32 * 256);
    p0 = __builtin_amdgcn_mfma_f32_32x32x16_bf16(b0, qr[d0], p0, 0, 0, 0);
    p1 = __builtin_amdgcn_mfma_f32_32x32x16_bf16(b1, qr[d0], p1, 0, 0, 0); }
}
template <int VB>
__device__ __forceinline__ void pv_tile(f32x16* o, int vb0, bf16x8 pa0, bf16x8 pa1, bf16x8 pa2, bf16x8 pa3) {
#define TRRD(dst, off) asm volatile("ds_read_b64_tr_b16 %0, %1 offset:%2" : "=&v"(dst) : "v"(vb0), "i"(off) : "memory")
#define PV_D0(d0) do { s16x4 l0, l1, l2, l3, h0, h1, h2, h3; constexpr int b_ = VB * SHM_V + v_rd_off(d0, 0, 0); \
    TRRD(l0, b_); TRRD(h0, b_ + 2048); TRRD(l1, b_ + 4096); TRRD(h1, b_ + 6144); TRRD(l2, b_ + 8192); TRRD(h2, b_ + 10240); TRRD(l3, b_ + 12288); TRRD(h3, b_ + 14336); \
    asm volatile("s_waitcnt lgkmcnt(0)" ::: "memory"); SBAR();   \
    o[d0] = __builtin_amdgcn_mfma_f32_32x32x16_bf16(pa0, (bf16x8){l0[0], l0[1], l0[2], l0[3], h0[0], h0[1], h0[2], h0[3]}, o[d0], 0, 0, 0);   \
    o[d0] = __builtin_amdgcn_mfma_f32_32x32x16_bf16(pa1, (bf16x8){l1[0], l1[1], l1[2], l1[3], h1[0], h1[1], h1[2], h1[3]}, o[d0], 0, 0, 0);   \
    o[d0] = __builtin_amdgcn_mfma_f32_32x32x16_bf16(pa2, (bf16x8){l2[0], l2[1], l2[2], l2[3], h2[0], h2[1], h2[2], h2[3]}, o[d0], 0, 0, 0);   \
    o[d0] = __builtin_amdgcn_mfma_f32_32x32x16_bf16(pa3, (bf16x8){l3[0], l3[1], l3[2], l3[3], h3[0], h3[1], h3[2], h3[3]}, o[d0], 0, 0, 0); } while (0)
  PV_D0(0); PV_D0(1); PV_D0(2); PV_D0(3);
#undef PV_D0
#undef TRRD
}

template <int MODE>
__device__ __forceinline__ void attn_pass(char* lds, const bf16_t* Kp, const bf16_t* Vp, const float* cump, float cref, int j_lo, int NT,
                                          const bf16x8* qr, int posq, unsigned long long sel, f32x16* o, float& m_reg, float& l_reg, float qbound = 0.f) {
  LAUNDER_IDS
  const int tid = tix, wid = __builtin_amdgcn_readfirstlane(tid >> 6), lane = tid & 63, r32 = lane & 31, hi = lane >> 5;
  char* V_lds = lds; char* K_lds = lds + 2 * SHM_V;
  float* wsc = (float*)(lds + AT_SCR) + wid * 64; float* al_l = wsc + 32;
  float* cb = (float*)(lds + AT_CB);
  volatile int* xflag = (volatile int*)(lds + AT_Q + 16);
  const int sr = tid >> 4, sc = (tid & 15) * 8, vst0 = v_st(sr, sc), vst1 = v_st(32 + sr, sc), kws = KSWZ(sr, sc * 2);
  const int vb0 = (int)(uintptr_t)V_lds + v_rd_base(lane);
  bf16x8 st_v0, st_v1, st_k0, st_k1; float st_c = 0.f, st_b = 0.f;
  const int wminpos = __builtin_amdgcn_readfirstlane(posq);
  m_reg = -1e30f; l_reg = 0.f;
#pragma unroll
  for (int d = 0; d < 4; ++d) o[d] = f32x16{};
#define TJ(t) (MODE == 0 ? (j_lo + NT - 1 - (t)) : (j_lo + (t)))
#define SLOAD(t) do { const size_t k0_ = (size_t)TJ(t) * 64; \
    st_v0 = *(const bf16x8*)(Vp + (k0_ + sr) * 128 + sc); st_v1 = *(const bf16x8*)(Vp + (k0_ + 32 + sr) * 128 + sc); \
    st_k0 = *(const bf16x8*)(Kp + (k0_ + sr) * 128 + sc); st_k1 = *(const bf16x8*)(Kp + (k0_ + 32 + sr) * 128 + sc); \
    if (MODE == 0) { if (tid < 64) st_c = (cref - cump[k0_ + tid]) * LOG2E; st_b = cump[k0_ + 63]; } } while (0)
#define SWRITE(bf) do { *(bf16x8*)(V_lds + (bf) * SHM_V + vst0) = st_v0; *(bf16x8*)(V_lds + (bf) * SHM_V + vst1) = st_v1; \
    *(bf16x8*)(K_lds + (bf) * SHM_K + kws) = st_k0; *(bf16x8*)(K_lds + (bf) * SHM_K + kws + 32 * 256) = st_k1; \
    if (MODE == 0 && tid < 64) cb[(bf) * 64 + tid] = st_c; } while (0)
#define STEP(t, BUF) do { \
    if ((t) + 1 < NT) SLOAD((t) + 1); \
    f32x16 p0, p1; \
    qkt<BUF>(p0, p1, K_lds, r32, hi, qr); \
    if (MODE == 0) { _Pragma("unroll") for (int i = 0; i < 4; ++i) { const f32x4 c0 = *(const f32x4*)(cb + (BUF) * 64 + 8 * i + 4 * hi); const f32x4 c1 = *(const f32x4*)(cb + (BUF) * 64 + 32 + 8 * i + 4 * hi); \
        _Pragma("unroll") for (int j = 0; j < 4; ++j) { p0[4 * i + j] = fmaf(p0[4 * i + j], C2, c0[j]); p1[4 * i + j] = fmaf(p1[4 * i + j], C2, c1[j]); } } } \
    { const int kb_ = TJ(t) * 64; \
      const bool need = (MODE == 1) || (kb_ + 63 > wminpos) || (MODE == 2 && kb_ + 511 < wminpos + 7); \
      if (need) mask_tile(p0, p1, posq - kb_ - 4 * hi, MODE == 2 ? 512u : 0x7fffffffu); } \
    const bool rsel = (MODE != 3) || (((sel >> TJ(t)) & 1ull) != 0ull); \
    float alpha; const bool dead = partialSM3<MODE>(p0, p1, m_reg, alpha, rsel); \
    if (!dead) { \
    if (__any(alpha < 1.f)) { if (hi == 0) al_l[r32] = alpha; asm volatile("s_waitcnt lgkmcnt(0)" ::: "memory"); \
      _Pragma("unroll") for (int d_ = 0; d_ < 4; ++d_) _Pragma("unroll") for (int r = 0; r < 16; ++r) o[d_][r] *= al_l[crow(r, hi)]; } \
    bf16x8 pa0, pa1, pa2, pa3; \
    finishSM3(p0, p1, alpha, l_reg, pa0, pa1, pa2, pa3); SBAR(); \
    pv_tile<BUF>(o, vb0, pa0, pa1, pa2, pa3); \
    } \
    if ((t) + 1 < NT) { asm volatile("s_waitcnt vmcnt(0)" ::: "memory"); SWRITE((BUF) ^ 1); } \
    if (MODE == 0 && (t) + 1 < NT) { const float bmax_ = (cref - st_b) * LOG2E;     \
      const bool done_ = __all(qbound + bmax_ - m_reg < -160.f); if (lane == 0) xflag[((t) & 1) * 8 + wid] = done_ ? 1 : 0; } \
    __syncthreads(); \
    if (MODE == 0 && (t) + 1 < NT) { int all_ = 1; _Pragma("unroll") for (int w_ = 0; w_ < 8; ++w_) all_ &= xflag[((t) & 1) * 8 + w_]; stop = all_ != 0; } } while (0)
  SLOAD(0); asm volatile("s_waitcnt vmcnt(0)" ::: "memory"); SWRITE(0); __syncthreads();
  bool stop = false;
  for (int t = 0; t < NT; t += 2) {
    STEP(t, 0);
    if (stop) break;
    if (t + 1 < NT) { STEP(t + 1, 1); if (stop) break; }
  }
#undef SLOAD
#undef SWRITE
#undef STEP
#undef TJ
}

__device__ __forceinline__ void cmp_importance(char* lds, const bf16_t* Kp, int NT, const bf16x8* qr, int nmax, float m_reg, float l_reg) {
  LAUNDER_IDS
  const int tid = tix, wid = __builtin_amdgcn_readfirstlane(tid >> 6), lane = tid & 63, r32 = lane & 31, hi = lane >> 5;
  char* K_lds = lds + 2 * SHM_V;
  float* U = (float*)(lds + AT_IMPU) + wid * 512; float* Wv = (float*)(lds + AT_IMPW) + wid * 512;
  const int sr = tid >> 4, sc = (tid & 15) * 8, kws = KSWZ(sr, sc * 2);
#pragma unroll
  for (int i = 0; i < 8; ++i) { U[i * 64 + lane] = 0.f; Wv[i * 64 + lane] = 0.f; }
  const float rl = l_reg > 0.f ? 1.f / l_reg : 0.f;
  const int tl = r32 >> 2;
  for (int t = 0; t < NT; ++t) {
    { const size_t k0 = (size_t)t * 64; const bf16x8 k0v = *(const bf16x8*)(Kp + (k0 + sr) * 128 + sc); const bf16x8 k1v = *(const bf16x8*)(Kp + (k0 + 32 + sr) * 128 + sc);
      *(bf16x8*)(K_lds + kws) = k0v; *(bf16x8*)(K_lds + kws + 32 * 256) = k1v; }
    __syncthreads();
    f32x16 p0, p1;
    qkt<0>(p0, p1, K_lds, r32, hi, qr);
#pragma unroll
    for (int r = 0; r < 16; ++r) { p0[r] *= C2; p1[r] *= C2; }
    mask_tile(p0, p1, nmax - t * 64 - 4 * hi, 0x7fffffffu);
#pragma unroll
    for (int r = 0; r < 16; ++r) { p0[r] = __builtin_amdgcn_exp2f(p0[r] - m_reg) * rl; p1[r] = __builtin_amdgcn_exp2f(p1[r] - m_reg) * rl; }
#pragma unroll
    for (int i = 0; i < 4; ++i) {
      float u0 = p0[4 * i] + p0[4 * i + 1] + p0[4 * i + 2] + 0.5f * p0[4 * i + 3], w0 = 0.5f * p0[4 * i + 3];
      float u1 = p1[4 * i] + p1[4 * i + 1] + p1[4 * i + 2] + 0.5f * p1[4 * i + 3], w1 = 0.5f * p1[4 * i + 3];
      u0 += __shfl_xor(u0, 1); u0 += __shfl_xor(u0, 2); w0 += __shfl_xor(w0, 1); w0 += __shfl_xor(w0, 2);
      u1 += __shfl_xor(u1, 1); u1 += __shfl_xor(u1, 2); w1 += __shfl_xor(w1, 1); w1 += __shfl_xor(w1, 2);
      if ((r32 & 3) == 0) { const int b0 = 16 * t + 2 * i + hi, b1 = b0 + 8;
        U[tl * 64 + b0] = u0; U[tl * 64 + b1] = u1; Wv[tl * 64 + b0 + 1] = w0; if (b1 + 1 < 64) Wv[tl * 64 + b1 + 1] = w1; }
    }
    __syncthreads();
  }
}

__device__ __forceinline__ unsigned long long topk_select(char* lds, int c) {
  LAUNDER_IDS
  const int tid = tix, wid = __builtin_amdgcn_readfirstlane(tid >> 6), lane = tid & 63, r32 = lane & 31;
  const float* U = (const float*)(lds + AT_IMPU) + wid * 512; const float* Wv = (const float*)(lds + AT_IMPW) + wid * 512;
  unsigned long long mysel = 0ull;
  for (int tl = 0; tl < 8; ++tl) {
    float v = U[tl * 64 + lane] + Wv[tl * 64 + lane];
    if (lane == 0 || lane == c || lane == c - 1) v = 1e6f; else if (lane > c) v = -1.f;
    int rank = 0;
#pragma unroll
    for (int i = 0; i < 64; ++i) { const float vi = __uint_as_float(__builtin_amdgcn_readlane(__float_as_uint(v), i)); rank += (vi > v || (vi == v && i < lane)) ? 1 : 0; }
    const unsigned long long m = __ballot(rank < 16 && v >= 0.f);
    if ((r32 >> 2) == tl) mysel = m;
  }
  return mysel;
}

template <int KIND>
__device__ __forceinline__ void attn_store(char* lds, const f32x16* o, float l_reg, const Params& p, int b, int hg, int P0, int br) {
  LAUNDER_IDS
  const int tid = tix, wid = __builtin_amdgcn_readfirstlane(tid >> 6), lane = tid & 63, r32 = lane & 31, hi = lane >> 5;
  float* li_l = (float*)(lds + AT_SCR) + wid * 64;
  if (hi == 0) li_l[r32] = l_reg; asm volatile("s_waitcnt lgkmcnt(0)" ::: "memory");
  bf16_t* __restrict__ oatt = (bf16_t*)(p.ws + WS_OATT); float* __restrict__ oacc = (float*)(p.ws + WS_ABUF); const float* __restrict__ small = (const float*)(p.ws + WS_SMALL);
  float sc[16];
#pragma unroll
  for (int r = 0; r < 16; ++r) { const int row = crow(r, hi); const float lv = li_l[row]; sc[r] = lv > 0.f ? __builtin_amdgcn_rcpf(lv) : 0.f; }
  if (KIND == 0) {
#pragma unroll
    for (int r = 0; r < 16; ++r) {
      const int row = crow(r, hi); const size_t tok = (size_t)b * 4096 + P0 + wid * 32 + row;
#pragma unroll
      for (int d0 = 0; d0 < 4; ++d0) { const float v = o[d0][r] * sc[r]; const float vn = __shfl_xor(v, 1);
        if ((r32 & 1) == 0) *(unsigned*)(oatt + tok * 2048 + hg * 128 + d0 * 32 + r32) = cvtpk(v, vn); }
    }
  } else {
    float gt[16];
#pragma unroll
    for (int r = 0; r < 16; ++r) { const int row = crow(r, hi); const int head = hg * 4 + (row & 3); const size_t tok = (size_t)b * 4096 + P0 + wid * 8 + (row >> 2);
      gt[r] = small[tok * 32 + 8 + head * 3 + br]; }
    float prev[16][4];
    if (KIND >= 2) {
#pragma unroll
      for (int r = 0; r < 16; ++r) { const int row = crow(r, hi); const int head = hg * 4 + (row & 3); const size_t tok = (size_t)b * 4096 + P0 + wid * 8 + (row >> 2);
        const float* ap = oacc + tok * 1024 + head * 128 + r32;
#pragma unroll
        for (int d0 = 0; d0 < 4; ++d0) prev[r][d0] = ap[d0 * 32]; }
    }
#pragma unroll
    for (int r = 0; r < 16; ++r) { const int row = crow(r, hi); const int head = hg * 4 + (row & 3); const size_t tok = (size_t)b * 4096 + P0 + wid * 8 + (row >> 2);
      const float scg = sc[r] * sigmoidf_(gt[r]);
      float* ap = oacc + tok * 1024 + head * 128 + r32;
#pragma unroll
      for (int d0 = 0; d0 < 4; ++d0) { float v = o[d0][r] * scg;
        if (KIND >= 2) v += prev[r][d0];
        if (KIND < 3) ap[d0 * 32] = v;
        else { const float vn = __shfl_xor(v, 1); if ((r32 & 1) == 0) *(unsigned*)(oatt + tok * 2048 + 1024 + head * 128 + d0 * 32 + r32) = cvtpk(v, vn); } } }
  }
}

__device__ __forceinline__ void attention_phase(const Params& p, int l, char* lds) {
  LAUNDER_IDS
  const int tid = tix, wid = __builtin_amdgcn_readfirstlane(tid >> 6), lane = tid & 63, r32 = lane & 31, hi = lane >> 5;
  unsigned* ctr = (unsigned*)(p.ws + WS_CTL) + l; const int* order = (const int*)(p.ws + WS_ORDER);
  volatile int* qslot = (volatile int*)(lds + AT_Q);
  const unsigned char* proj = p.ws + WS_PROJ;
  for (;;) {
    if (tid == 0) *qslot = (int)atomicAdd(ctr, 1u);
    __syncthreads();
    const int qi = *qslot;
    __syncthreads();
    if (qi >= 1024 + T_FFN) break;
    if (qi >= 1024) { convert_ffn_tile(p, l, qi - 1024, (float*)lds); continue; }
    const int id = order[qi];
    bf16x8 qr[8]; f32x16 o[4]; float m_reg, l_reg;
    if (id < 512) {
      const int b = id >> 7, h = (id >> 4) & 7, xq = id & 15, P0 = xq * 256; const int bh = b * 8 + h;
      const bf16_t* Q = (const bf16_t*)(proj + PJ_FQ) + (size_t)bh * 4096 * 128; const bf16_t* K = (const bf16_t*)(proj + PJ_FK) + (size_t)bh * 4096 * 128; const bf16_t* V = (const bf16_t*)(proj + PJ_FV) + (size_t)bh * 4096 * 128;
      const float* cum = (const float*)(p.ws + WS_CUM) + bh * 4096;
      const int pos = P0 + wid * 32 + r32;
#pragma unroll
      for (int d0 = 0; d0 < 8; ++d0) qr[d0] = *(const bf16x8*)(Q + (size_t)pos * 128 + d0 * 16 + hi * 8);
      float qb;
      { float qs = 0.f;
#pragma unroll
        for (int d0 = 0; d0 < 8; ++d0) { const u32x4 w = *reinterpret_cast<const u32x4*>(&qr[d0]);
          qs += bflo(w.x) * bflo(w.x) + bfhi(w.x) * bfhi(w.x) + bflo(w.y) * bflo(w.y) + bfhi(w.y) * bfhi(w.y) + bflo(w.z) * bflo(w.z) + bfhi(w.z) * bfhi(w.z) + bflo(w.w) * bflo(w.w) + bfhi(w.w) * bfhi(w.w); }
        auto rr = __builtin_amdgcn_permlane32_swap(__float_as_uint(qs), __float_as_uint(qs), false, false);
        qs = __uint_as_float(rr[0]) + __uint_as_float(rr[1]);
        const float k2 = __uint_as_float(((const unsigned*)(p.ws + WS_CTL + 256))[l * 32 + bh]);
        qb = sqrtf(qs * k2) * (C2 * 1.01f) + 1.f; }
      attn_pass<0>(lds, K, V, cum, cum[P0], 0, 4 * (xq + 1), qr, pos, 0ull, o, m_reg, l_reg, qb);
      attn_store<0>(lds, o, l_reg, p, b, h, P0, 0);
    } else {
      const int n = id - 512, b = n >> 7, g = (n >> 6) & 1, c = n & 63, P0 = c * 64; const int bg = b * 2 + g;
      const int pos = P0 + wid * 8 + (r32 >> 2); const int head = g * 4 + (r32 & 3);
      const bf16_t* Q = (const bf16_t*)(proj + PJ_NQ) + ((size_t)(b * 8 + head) * 4096 + pos) * 128;
#pragma unroll
      for (int d0 = 0; d0 < 8; ++d0) qr[d0] = *(const bf16x8*)(Q + d0 * 16 + hi * 8);
      const bf16_t* kvb = (const bf16_t*)(proj + PJ_KV);
      const size_t kvo = (size_t)bg * 4096 * 128, kvs = SZ_KV / 2;
      const bf16_t* Kc = (const bf16_t*)(p.ws + WS_KC) + (size_t)bg * 256 * 128; const bf16_t* Vc = (const bf16_t*)(p.ws + WS_VC) + (size_t)bg * 256 * 128;
      int nmax = (pos >= 31) ? ((pos - 31) >> 4) : -1; if (nmax > 254) nmax = 254;
      const int NTc = (4 * c + 2) / 64 + 1;
      attn_pass<1>(lds, Kc, Vc, nullptr, 0.f, 0, NTc, qr, nmax, 0ull, o, m_reg, l_reg);
      attn_store<1>(lds, o, l_reg, p, b, g, P0, 0);
      cmp_importance(lds, Kc, NTc, qr, nmax, m_reg, l_reg);
      const unsigned long long sel = topk_select(lds, c);
      { const int jl = c >= 8 ? c - 8 : 0;
        attn_pass<2>(lds, kvb + 4 * kvs + kvo, kvb + 5 * kvs + kvo, nullptr, 0.f, jl, c - jl + 1, qr, pos, 0ull, o, m_reg, l_reg);
        attn_store<2>(lds, o, l_reg, p, b, g, P0, 2); }
      attn_pass<3>(lds, kvb + 2 * kvs + kvo, kvb + 3 * kvs + kvo, nullptr, 0.f, 0, c + 1, qr, pos, sel, o, m_reg, l_reg);
      attn_store<3>(lds, o, l_reg, p, b, g, P0, 1);
    }
  }
}


#define XB_TMO      128
#define XB_XCNT(j)  (256  + 64 * (j))
#define XB_XSUB(j)  (1280 + 64 * (j))
#define XB_XGEN(j)  (2304 + 64 * (j))
#define XB_TOP      3328
#define XB_TOPGEN   3392
#define XCD_BAR_WORDS 3456
#define XB_SPIN_CAP (1u << 18)
__device__ __forceinline__ unsigned xb_ld(unsigned* p)              { return __hip_atomic_load(p, __ATOMIC_RELAXED, __HIP_MEMORY_SCOPE_AGENT); }
__device__ __forceinline__ unsigned xb_add(unsigned* p, unsigned v) { return __hip_atomic_fetch_add(p, v, __ATOMIC_RELAXED, __HIP_MEMORY_SCOPE_AGENT); }
__device__ __forceinline__ unsigned xb_xcc_id() { return (unsigned)__builtin_amdgcn_s_getreg((3 << 11) | 20) & 0xFu; }
#define XB_SPIN(cond, bar) do { unsigned _sp = 0; while (cond) { __builtin_amdgcn_s_sleep(1); \
    if ((++_sp & 255u) == 0u) { if (xb_ld(&(bar)[XB_TMO])) break; if (_sp > XB_SPIN_CAP) { atomicAdd(&(bar)[XB_TMO], 1u); break; } } } } while (0)
struct XcdBarrier { unsigned* bar; unsigned x; volatile LAS unsigned* st; };
__device__ __forceinline__ XcdBarrier xcd_barrier_post(unsigned* bar, volatile LAS unsigned* st) {
    XcdBarrier b; b.bar = bar; b.x = xb_xcc_id(); b.st = st;
    if (threadIdx.x == 0) (void)xb_add(&bar[XB_XCNT(b.x)], 1u);
    return b;
}
__device__ __forceinline__ void xcd_barrier_complete(unsigned* bar, unsigned x, unsigned& nloc, unsigned& nx) {
    const unsigned G = gridDim.x * gridDim.y * gridDim.z;
    unsigned sum, cnt, mine, sp = 0u;
    for (;;) {
        sum = 0u; cnt = 0u; mine = 0u;
#pragma unroll
        for (unsigned j = 0; j < 16; ++j) { const unsigned c = xb_ld(&bar[XB_XCNT(j)]); sum += c; cnt += (c > 0u) ? 1u : 0u; mine = (j == x) ? c : mine; }
        if (sum == G) break;
        __builtin_amdgcn_s_sleep(1);
        if ((++sp & 255u) == 0u) { if (xb_ld(&bar[XB_TMO])) break; if (sp > XB_SPIN_CAP) { atomicAdd(&bar[XB_TMO], 1u); break; } }
    }
    nloc = mine > 0u ? mine : 1u; nx = cnt > 0u ? cnt : 1u;
}
__device__ __attribute__((noinline)) void xcd_barrier_impl(unsigned* bar_, unsigned bx_, volatile LAS unsigned* st_) {
    XcdBarrier b; b.bar = bar_; b.x = bx_; b.st = st_;
    asm volatile("s_waitcnt vmcnt(0)" ::: "memory");
    __syncthreads();
    if (threadIdx.x == 0) {
        unsigned* bar = b.bar;
        __builtin_amdgcn_s_waitcnt(0);
        unsigned nloc = b.st[0], nx = b.st[1];
        if (nloc == 0u) { xcd_barrier_complete(bar, b.x, nloc, nx); b.st[0] = nloc; b.st[1] = nx; }
        const unsigned old = xb_add(&bar[XB_XSUB(b.x)], 1u);
        const unsigned gen = old / nloc;
        if (old + 1u == (gen + 1u) * nloc) {
            __builtin_amdgcn_fence(__ATOMIC_RELEASE, "agent");
            asm volatile("s_waitcnt vmcnt(0)" ::: "memory");
            const unsigned og = xb_add(&bar[XB_TOP], 1u);
            const unsigned tg = og / nx;
            if (og + 1u == (tg + 1u) * nx) xb_add(&bar[XB_TOPGEN], 1u);
            else XB_SPIN(xb_ld(&bar[XB_TOPGEN]) == tg, bar);
            __builtin_amdgcn_fence(__ATOMIC_ACQUIRE, "agent");
            xb_add(&bar[XB_XGEN(b.x)], 1u);
            asm volatile("s_waitcnt vmcnt(0)" ::: "memory");
        } else {
            XB_SPIN(xb_ld(&bar[XB_XGEN(b.x)]) == gen, bar);
            __builtin_amdgcn_fence(__ATOMIC_ACQUIRE, "agent");
            asm volatile("s_waitcnt vmcnt(0)" ::: "memory");
        }
    }
    __syncthreads();
}

__global__ void __launch_bounds__(NTHR, 2) mega(Params p_arg) {
  typedef const __attribute__((address_space(4))) Params* KP;
  const KP kp0 = (KP)__builtin_amdgcn_kernarg_segment_ptr();
  (void)p_arg;
  extern __shared__ __attribute__((aligned(16))) unsigned char lds[];
  cg::grid_group grid = cg::this_grid();
  LAS unsigned char* ldsl = (LAS unsigned char*)lds;
  constexpr int ST_OFF = 136 * 1024 - 64;
  if (threadIdx.x < 4) ((LAS unsigned*)(ldsl + ST_OFF))[threadIdx.x] = 0u;
  __syncthreads();
    { KP kp = kp0; asm volatile("" : "+s"(kp)); const Params p = *(const Params*)kp; unsigned char* ws = p.ws; unsigned char* wt = ws + WS_WT; unsigned char* proj = ws + WS_PROJ; bf16_t* abuf = (bf16_t*)(ws + WS_ABUF); bf16_t* oatt = (bf16_t*)(ws + WS_OATT); bf16_t* ybuf = (bf16_t*)(ws + WS_Y); float* ssq = (float*)(ws + WS_SSQ); float* small = (float*)(ws + WS_SMALL); (void)wt; (void)proj; (void)abuf; (void)oatt; (void)ybuf; (void)ssq; (void)small;
  if (blockIdx.x == 0) sort_items(p, (int*)lds);
  rope_tables(p);
  convert_mixer(p, 0, (float*)lds);
  row_phase(0, p.x, nullptr, nullptr, nullptr, nullptr, p.n_mix_pre, abuf);
    }
  grid.sync();
  const XcdBarrier xbar = xcd_barrier_post((unsigned*)(((const Params*)kp0)->ws + WS_BAR), (volatile LAS unsigned*)(ldsl + ST_OFF));

  for (int l = 0; l < 2; ++l) {
    { KP kp = kp0; asm volatile("" : "+s"(kp)); const Params p = *(const Params*)kp; unsigned char* ws = p.ws; unsigned char* wt = ws + WS_WT; unsigned char* proj = ws + WS_PROJ; bf16_t* abuf = (bf16_t*)(ws + WS_ABUF); bf16_t* oatt = (bf16_t*)(ws + WS_OATT); bf16_t* ybuf = (bf16_t*)(ws + WS_Y); float* ssq = (float*)(ws + WS_SSQ); float* small = (float*)(ws + WS_SMALL); (void)wt; (void)proj; (void)abuf; (void)oatt; (void)ybuf; (void)ssq; (void)small;
    { StaticOrder S; S.init(abuf, (const bf16_t*)(wt + WT_IN), DM, DM, NTOK, INP);
      EpiIn E{proj, small, (const float*)(ws + WS_ROPEQ)};
      gemm_phase<EpiIn, StaticOrder>(ldsl, DM, DM, DM, S, E); }
    }
    xcd_barrier_impl(xbar.bar, xbar.x, xbar.st);
    { KP kp = kp0; asm volatile("" : "+s"(kp)); const Params p = *(const Params*)kp; unsigned char* ws = p.ws; unsigned char* wt = ws + WS_WT; unsigned char* proj = ws + WS_PROJ; bf16_t* abuf = (bf16_t*)(ws + WS_ABUF); bf16_t* oatt = (bf16_t*)(ws + WS_OATT); bf16_t* ybuf = (bf16_t*)(ws + WS_Y); float* ssq = (float*)(ws + WS_SSQ); float* small = (float*)(ws + WS_SMALL); (void)wt; (void)proj; (void)abuf; (void)oatt; (void)ybuf; (void)ssq; (void)small;
    cumsum_phase(p, l, (float*)lds);
    kmax_phase(p, l);
    { CmpOrder S{(const bf16_t*)(proj + PJ_KV), (const bf16_t*)(proj + PJ_KV + SZ_KV), (const bf16_t*)(wt + WT_C1K), (const bf16_t*)(wt + WT_C1V), (int)gridDim.x, launder_s((int)blockIdx.x)};
      EpiPartial E{(bf16_t*)(ws + WS_Y)};
      gemm_phase<EpiPartial, CmpOrder>(ldsl, 2048, 4096, 256, S, E); }
    }
    xcd_barrier_impl(xbar.bar, xbar.x, xbar.st);
    { KP kp = kp0; asm volatile("" : "+s"(kp)); const Params p = *(const Params*)kp; unsigned char* ws = p.ws; unsigned char* wt = ws + WS_WT; unsigned char* proj = ws + WS_PROJ; bf16_t* abuf = (bf16_t*)(ws + WS_ABUF); bf16_t* oatt = (bf16_t*)(ws + WS_OATT); bf16_t* ybuf = (bf16_t*)(ws + WS_Y); float* ssq = (float*)(ws + WS_SSQ); float* small = (float*)(ws + WS_SMALL); (void)wt; (void)proj; (void)abuf; (void)oatt; (void)ybuf; (void)ssq; (void)small;
    cmp_finish(p, l, (float*)lds);
    }
    xcd_barrier_impl(xbar.bar, xbar.x, xbar.st);
    { KP kp = kp0; asm volatile("" : "+s"(kp)); const Params p = *(const Params*)kp; unsigned char* ws = p.ws; unsigned char* wt = ws + WS_WT; unsigned char* proj = ws + WS_PROJ; bf16_t* abuf = (bf16_t*)(ws + WS_ABUF); bf16_t* oatt = (bf16_t*)(ws + WS_OATT); bf16_t* ybuf = (bf16_t*)(ws + WS_Y); float* ssq = (float*)(ws + WS_SSQ); float* small = (float*)(ws + WS_SMALL); (void)wt; (void)proj; (void)abuf; (void)oatt; (void)ybuf; (void)ssq; (void)small;
    attention_phase(p, l, (char*)lds);
    }
    xcd_barrier_impl(xbar.bar, xbar.x, xbar.st);
    { KP kp = kp0; asm volatile("" : "+s"(kp)); const Params p = *(const Params*)kp; unsigned char* ws = p.ws; unsigned char* wt = ws + WS_WT; unsigned char* proj = ws + WS_PROJ; bf16_t* abuf = (bf16_t*)(ws + WS_ABUF); bf16_t* oatt = (bf16_t*)(ws + WS_OATT); bf16_t* ybuf = (bf16_t*)(ws + WS_Y); float* ssq = (float*)(ws + WS_SSQ); float* small = (float*)(ws + WS_SMALL); (void)wt; (void)proj; (void)abuf; (void)oatt; (void)ybuf; (void)ssq; (void)small;
    { CatOrder S; S.base.init(oatt, (const bf16_t*)(ws + WS_WT2 + W2_UPF), DM, 1024, NTOK, DM); S.B1 = (const bf16_t*)(ws + WS_WT2 + W2_UPN);
      EpiUpCat E{(const bf16_t*)(proj + PJ_GF), (const bf16_t*)(proj + PJ_GN), abuf};
      gemm_phase<EpiUpCat, CatOrder>(ldsl, DM, 1024, 1024, S, E); }
    }
    xcd_barrier_impl(xbar.bar, xbar.x, xbar.st);
    { KP kp = kp0; asm volatile("" : "+s"(kp)); const Params p = *(const Params*)kp; unsigned char* ws = p.ws; unsigned char* wt = ws + WS_WT; unsigned char* proj = ws + WS_PROJ; bf16_t* abuf = (bf16_t*)(ws + WS_ABUF); bf16_t* oatt = (bf16_t*)(ws + WS_OATT); bf16_t* ybuf = (bf16_t*)(ws + WS_Y); float* ssq = (float*)(ws + WS_SSQ); float* small = (float*)(ws + WS_SMALL); (void)wt; (void)proj; (void)abuf; (void)oatt; (void)ybuf; (void)ssq; (void)small;
    { StaticOrder S; S.init(abuf, (const bf16_t*)(ws + WS_WT2 + W2_OUT), DM, DM, NTOK, DM);
      EpiY E{ybuf, ssq};
      gemm_phase<EpiY, StaticOrder>(ldsl, DM, DM, DM, S, E); }
    }
    xcd_barrier_impl(xbar.bar, xbar.x, xbar.st);
    { KP kp = kp0; asm volatile("" : "+s"(kp)); const Params p = *(const Params*)kp; unsigned char* ws = p.ws; unsigned char* wt = ws + WS_WT; unsigned char* proj = ws + WS_PROJ; bf16_t* abuf = (bf16_t*)(ws + WS_ABUF); bf16_t* oatt = (bf16_t*)(ws + WS_OATT); bf16_t* ybuf = (bf16_t*)(ws + WS_Y); float* ssq = (float*)(ws + WS_SSQ); float* small = (float*)(ws + WS_SMALL); (void)wt; (void)proj; (void)abuf; (void)oatt; (void)ybuf; (void)ssq; (void)small;
    const float* xin = (l == 0) ? p.x : p.out;
    row_phase(1, xin, p.out, ybuf, ssq, p.n_mix_post + l * DM, p.n_ffn_pre + l * DM, abuf);
    }
    xcd_barrier_impl(xbar.bar, xbar.x, xbar.st);
    { KP kp = kp0; asm volatile("" : "+s"(kp)); const Params p = *(const Params*)kp; unsigned char* ws = p.ws; unsigned char* wt = ws + WS_WT; unsigned char* proj = ws + WS_PROJ; bf16_t* abuf = (bf16_t*)(ws + WS_ABUF); bf16_t* oatt = (bf16_t*)(ws + WS_OATT); bf16_t* ybuf = (bf16_t*)(ws + WS_Y); float* ssq = (float*)(ws + WS_SSQ); float* small = (float*)(ws + WS_SMALL); (void)wt; (void)proj; (void)abuf; (void)oatt; (void)ybuf; (void)ssq; (void)small;
    { StaticOrder S; S.init(abuf, (const bf16_t*)(wt + WT_GU), DM, DM, NTOK, 2 * FFH);
      EpiSwiglu E{(bf16_t*)proj};
      gemm_phase<EpiSwiglu, StaticOrder>(ldsl, DM, DM, DM, S, E); }
    }
    xcd_barrier_impl(xbar.bar, xbar.x, xbar.st);
    { KP kp = kp0; asm volatile("" : "+s"(kp)); const Params p = *(const Params*)kp; unsigned char* ws = p.ws; unsigned char* wt = ws + WS_WT; unsigned char* proj = ws + WS_PROJ; bf16_t* abuf = (bf16_t*)(ws + WS_ABUF); bf16_t* oatt = (bf16_t*)(ws + WS_OATT); bf16_t* ybuf = (bf16_t*)(ws + WS_Y); float* ssq = (float*)(ws + WS_SSQ); float* small = (float*)(ws + WS_SMALL); (void)wt; (void)proj; (void)abuf; (void)oatt; (void)ybuf; (void)ssq; (void)small;
    { StaticOrder S; S.init((const bf16_t*)proj, (const bf16_t*)(wt + WT_DOWN), FFH, FFH, NTOK, DM);
      EpiY E{ybuf, ssq};
      gemm_phase<EpiY, StaticOrder>(ldsl, FFH, FFH, FFH, S, E); }
    }
    xcd_barrier_impl(xbar.bar, xbar.x, xbar.st);
    { KP kp = kp0; asm volatile("" : "+s"(kp)); const Params p = *(const Params*)kp; unsigned char* ws = p.ws; unsigned char* wt = ws + WS_WT; unsigned char* proj = ws + WS_PROJ; bf16_t* abuf = (bf16_t*)(ws + WS_ABUF); bf16_t* oatt = (bf16_t*)(ws + WS_OATT); bf16_t* ybuf = (bf16_t*)(ws + WS_Y); float* ssq = (float*)(ws + WS_SSQ); float* small = (float*)(ws + WS_SMALL); (void)wt; (void)proj; (void)abuf; (void)oatt; (void)ybuf; (void)ssq; (void)small;
    if (l == 0) convert_mixer(p, 1, (float*)lds);
    row_phase(1, p.out, p.out, ybuf, ssq, p.n_ffn_post + l * DM, (l == 0) ? p.n_mix_pre + DM : nullptr, abuf);
    }
    if (l == 0) xcd_barrier_impl(xbar.bar, xbar.x, xbar.st);
  }
}

extern "C" void kernel_launch(void* const* d_in, const int* in_sizes, int n_in, void* d_out, int out_size, void* d_ws, size_t ws_size, hipStream_t stream) {
  constexpr int LDSB = 136 * 1024;
  static_assert(AT_END <= LDSB && STAGE_BYTES <= LDSB, "lds");
  static int grid_blocks = 0;
  if (!grid_blocks) {
    int dev = 0, cus = 0, per_cu = 0;
    (void)hipGetDevice(&dev);
    (void)hipDeviceGetAttribute(&cus, hipDeviceAttributeMultiprocessorCount, dev);
    (void)hipFuncSetAttribute((const void*)mega, hipFuncAttributeMaxDynamicSharedMemorySize, LDSB);
    (void)hipOccupancyMaxActiveBlocksPerMultiprocessor(&per_cu, (const void*)mega, NTHR, LDSB);
    if (per_cu < 1) per_cu = 1;
    grid_blocks = cus * 1;
    if (ws_size < WS_END) fprintf(stderr, "workspace too small: %zu < %zu\n", ws_size, (size_t)WS_END);
    fprintf(stderr, "grid %d (cus %d per_cu %d) ws %zu need %zu\n", grid_blocks, cus, per_cu, ws_size, (size_t)WS_END);
  }
  Params p{};
  p.x = (const float*)d_in[0]; p.n_mix_pre = (const float*)d_in[1]; p.n_mix_post = (const float*)d_in[2]; p.n_ffn_pre = (const float*)d_in[3]; p.n_ffn_post = (const float*)d_in[4];
  p.w_in = (const float*)d_in[5]; p.f_bias = (const float*)d_in[6]; p.ck_pe = (const float*)d_in[7]; p.ck_w1 = (const float*)d_in[8]; p.ck_w2 = (const float*)d_in[9];
  p.cv_pe = (const float*)d_in[10]; p.cv_w1 = (const float*)d_in[11]; p.cv_w2 = (const float*)d_in[12]; p.w_up_fox = (const float*)d_in[13]; p.w_up_nsa = (const float*)d_in[14];
  p.w_out = (const float*)d_in[15]; p.w_gate = (const float*)d_in[16]; p.w_up = (const float*)d_in[17]; p.w_down = (const float*)d_in[18];
  p.out = (float*)d_out; p.ws = (unsigned char*)d_ws;
  void* args[] = {&p};
  hipError_t e = hipLaunchCooperativeKernel((const void*)mega, dim3(grid_blocks), dim3(NTHR), args, LDSB, stream);
  if (e != hipSuccess) fprintf(stderr, "cooperative launch failed: %s (grid %d)\n", hipGetErrorString(e), grid_blocks);
}
```
